# Optimizing an MI355X kernel written in HIP

```python
import jax, jax.numpy as jnp
from jax import lax
import numpy as np

D_MODEL = 2048
BATCH = 1
SEQ = 8192
DEPTH = 1

MEM_LEN = 256
D_MIX = 2 * D_MODEL
GM_WIDTH = D_MODEL // 2 * 2 // 2 * 2 // 2
GM_WIDTH = D_MIX // 2
GM_GROUPS = 4
GM_CHUNK = 128
SSM_WIDTH = D_MIX - GM_WIDTH
SSM_HEADDIM = 64
SSM_HEADS = SSM_WIDTH // SSM_HEADDIM
SSM_GROUPS = 8
SSM_STATE = 128
SSM_CONV = 4
SSM_CHUNK = 128
SSM_CONV_CH = SSM_WIDTH + 2 * SSM_GROUPS * SSM_STATE
IN_COLS = 2 * GM_WIDTH + SSM_WIDTH + SSM_CONV_CH + SSM_HEADS
XA_HEADS = 4
XA_HEADDIM = D_MODEL // XA_HEADS
D_FF = 5632
EPS = 1e-6

kernel_name = "hybrid_gmlp_ssd_macaron_memxattn"


def rmsnorm(x, w):
    xf = x.astype(jnp.float32)
    y = xf * lax.rsqrt(jnp.mean(xf * xf, axis=-1, keepdims=True) + EPS)
    return (y * w.astype(jnp.float32)).astype(x.dtype)


def swiglu(x, w_gu, w_down):
    g, u = jnp.split(x @ w_gu, 2, axis=-1)
    return (jax.nn.silu(g) * u) @ w_down


def chunked_sgu(u, v, v_norm_w, w_s, b_s):
    bn, s, _ = u.shape
    nc = s // GM_CHUNK
    cg = GM_WIDTH // GM_GROUPS
    v = rmsnorm(v, v_norm_w).reshape(bn, nc, GM_CHUNK, GM_GROUPS, cg)
    causal = jnp.tril(jnp.ones((GM_CHUNK, GM_CHUNK), dtype=bool))
    w = jnp.where(causal[None], w_s, jnp.zeros_like(w_s)).astype(v.dtype)
    mixed = jnp.einsum('gts,bcsgd->bctgd', w, v) + b_s.T.astype(v.dtype)[None, None, :, :, None]
    return u * mixed.reshape(bn, s, GM_WIDTH)


def causal_dwconv(x, w, b):
    k_w = w.shape[0]
    s = x.shape[1]
    xp = jnp.pad(x, ((0, 0), (k_w - 1, 0), (0, 0)))
    y = b + xp[:, 0:s] * w[0]
    for k in range(1, k_w):
        y = y + xp[:, k:k + s] * w[k]
    return y


def ssd_scan(x, dt, a, bm, cm):
    bn, s, h, p = x.shape
    g, n = bm.shape[-2:]
    r = h // g
    l = SSM_CHUNK
    nc = s // l
    x = x.reshape(bn, nc, l, g, r, p)
    dt = dt.reshape(bn, nc, l, g, r)
    bm = bm.reshape(bn, nc, l, g, n)
    cm = cm.reshape(bn, nc, l, g, n)
    cum = jnp.cumsum(dt * a.reshape(g, r), axis=2)
    xdt = x * dt[..., None]
    seg = cum[:, :, :, None] - cum[:, :, None]
    causal = jnp.tril(jnp.ones((l, l), dtype=bool))[:, :, None, None]
    decay = jnp.exp(jnp.where(causal, seg, -jnp.inf))
    scores = jnp.einsum('bclgn,bcsgn->bclsg', cm, bm)
    y_diag = jnp.einsum('bclsg,bclsgr,bcsgrp->bclgrp', scores, decay, xdt)
    decay_end = jnp.exp(cum[:, :, -1:] - cum)
    states = jnp.einsum('bclgn,bclgr,bclgrp->bcgrpn', bm, decay_end, xdt)
    chunk_decay = jnp.exp(cum[:, :, -1])

    def step(carry, inp):
        st, dec = inp
        return carry * dec[..., None, None] + st, carry

    init = jnp.zeros((bn, g, r, p, n), jnp.float32)
    _, prev = lax.scan(step, init, (jnp.moveaxis(states, 1, 0), jnp.moveaxis(chunk_decay, 1, 0)))
    prev = jnp.moveaxis(prev, 0, 1)
    y_off = jnp.einsum('bclgn,bcgrpn,bclgr->bclgrp', cm, prev, jnp.exp(cum))
    return (y_diag + y_off).reshape(bn, s, h, p)


def mamba2_group(z, xbc, dt_raw, conv_w, conv_b, dt_bias, a_log, d_skip, norm_w):
    f32 = jnp.float32
    xbc = jax.nn.silu(causal_dwconv(xbc, conv_w, conv_b))
    gn = SSM_GROUPS * SSM_STATE
    xs, bm, cm = jnp.split(xbc, [SSM_WIDTH, SSM_WIDTH + gn], axis=-1)
    bn, s, _ = xs.shape
    x_h = xs.reshape(bn, s, SSM_HEADS, SSM_HEADDIM).astype(f32)
    dt = jax.nn.softplus(dt_raw.astype(f32) + dt_bias.astype(f32))
    a = -jnp.exp(a_log.astype(f32))
    y = ssd_scan(x_h, dt, a,
                 bm.reshape(bn, s, SSM_GROUPS, SSM_STATE).astype(f32),
                 cm.reshape(bn, s, SSM_GROUPS, SSM_STATE).astype(f32))
    y = y + d_skip.astype(f32)[:, None] * x_h
    y = y.reshape(bn, s, SSM_WIDTH) * jax.nn.silu(z.astype(f32))
    return rmsnorm(y, norm_w).astype(z.dtype)


def memory_cross_attention(hn, memn, w_q, w_kv, w_o):
    bn, s, _ = hn.shape
    m = memn.shape[1]
    q = (hn @ w_q).reshape(bn, s, XA_HEADS, XA_HEADDIM)
    k, v = jnp.split(memn @ w_kv, 2, axis=-1)
    k = k.reshape(bn, m, XA_HEADS, XA_HEADDIM)
    v = v.reshape(bn, m, XA_HEADS, XA_HEADDIM)
    logits = jnp.einsum('bshd,bmhd->bhsm', q, k).astype(jnp.float32) * (XA_HEADDIM ** -0.5)
    probs = jax.nn.softmax(logits, axis=-1).astype(v.dtype)
    o = jnp.einsum('bhsm,bmhd->bshd', probs, v).reshape(bn, s, D_MODEL)
    return o @ w_o


def setup_inputs(seed: int = 0) -> dict:
    key = jax.random.key(seed)
    ks = jax.random.split(key, 32)
    f32 = jnp.float32

    def nrm(k, shape, scale):
        return jax.random.normal(k, shape, f32) * scale

    def gain(k, shape):
        return 1.0 + 0.1 * jax.random.normal(k, shape, f32)

    L = DEPTH
    dt0 = jnp.exp(jax.random.uniform(ks[12], (L, SSM_HEADS), f32) * (np.log(0.1) - np.log(0.001)) + np.log(0.001))
    dt_bias = dt0 + jnp.log(-jnp.expm1(-dt0))
    return {
        "x": nrm(ks[0], (BATCH, SEQ, D_MODEL), 1.0),
        "mem": nrm(ks[1], (BATCH, MEM_LEN, D_MODEL), 1.0),
        "ffn1_norm": gain(ks[2], (L, D_MODEL)),
        "ffn1_w_gu": nrm(ks[3], (L, D_MODEL, 2 * D_FF), D_MODEL ** -0.5),
        "ffn1_w_down": nrm(ks[4], (L, D_FF, D_MODEL), D_FF ** -0.5),
        "mix_norm": gain(ks[5], (L, D_MODEL)),
        "w_in": nrm(ks[6], (L, D_MODEL, IN_COLS), D_MODEL ** -0.5),
        "gm_v_norm": gain(ks[7], (L, GM_WIDTH)),
        "gm_w_s": nrm(ks[8], (L, GM_GROUPS, GM_CHUNK, GM_CHUNK), GM_CHUNK ** -0.5),
        "gm_b_s": gain(ks[9], (L, GM_GROUPS, GM_CHUNK)),
        "ssm_conv_w": nrm(ks[10], (L, SSM_CONV, SSM_CONV_CH), SSM_CONV ** -0.5),
        "ssm_conv_b": nrm(ks[11], (L, SSM_CONV_CH), 0.02),
        "ssm_dt_bias": dt_bias,
        "ssm_a_log": jnp.log(jax.random.uniform(ks[13], (L, SSM_HEADS), f32, 1.0, 16.0)),
        "ssm_d": gain(ks[14], (L, SSM_HEADS)),
        "ssm_norm": gain(ks[15], (L, SSM_WIDTH)),
        "w_out": nrm(ks[16], (L, D_MIX, D_MODEL), D_MIX ** -0.5),
        "xa_norm": gain(ks[17], (L, D_MODEL)),
        "mem_norm": gain(ks[18], (L, D_MODEL)),
        "xa_w_q": nrm(ks[19], (L, D_MODEL, D_MODEL), D_MODEL ** -0.5),
        "xa_w_kv": nrm(ks[20], (L, D_MODEL, 2 * D_MODEL), D_MODEL ** -0.5),
        "xa_w_o": nrm(ks[21], (L, D_MODEL, D_MODEL), D_MODEL ** -0.5),
        "ffn2_norm": gain(ks[22], (L, D_MODEL)),
        "ffn2_w_gu": nrm(ks[23], (L, D_MODEL, 2 * D_FF), D_MODEL ** -0.5),
        "ffn2_w_down": nrm(ks[24], (L, D_FF, D_MODEL), D_FF ** -0.5),
        "final_norm": gain(ks[25], (D_MODEL,)),
    }


def reference(x, mem, ffn1_norm, ffn1_w_gu, ffn1_w_down, mix_norm, w_in, gm_v_norm, gm_w_s, gm_b_s,
              ssm_conv_w, ssm_conv_b, ssm_dt_bias, ssm_a_log, ssm_d, ssm_norm, w_out,
              xa_norm, mem_norm, xa_w_q, xa_w_kv, xa_w_o, ffn2_norm, ffn2_w_gu, ffn2_w_down, final_norm):
    h = x
    split_at = [GM_WIDTH, 2 * GM_WIDTH, 2 * GM_WIDTH + SSM_WIDTH, 2 * GM_WIDTH + SSM_WIDTH + SSM_CONV_CH]
    for i in range(DEPTH):
        h = h + 0.5 * swiglu(rmsnorm(h, ffn1_norm[i]), ffn1_w_gu[i], ffn1_w_down[i])
        proj = rmsnorm(h, mix_norm[i]) @ w_in[i]
        gu, gv, z, xbc, dt_raw = jnp.split(proj, split_at, axis=-1)
        a_out = chunked_sgu(jax.nn.gelu(gu), jax.nn.gelu(gv), gm_v_norm[i], gm_w_s[i], gm_b_s[i])
        m_out = mamba2_group(z, xbc, dt_raw, ssm_conv_w[i], ssm_conv_b[i], ssm_dt_bias[i],
                             ssm_a_log[i], ssm_d[i], ssm_norm[i])
        h = h + jnp.concatenate([a_out, m_out], axis=-1) @ w_out[i]
        h = h + memory_cross_attention(rmsnorm(h, xa_norm[i]), rmsnorm(mem, mem_norm[i]),
                                       xa_w_q[i], xa_w_kv[i], xa_w_o[i])
        h = h + 0.5 * swiglu(rmsnorm(h, ffn2_norm[i]), ffn2_w_gu[i], ffn2_w_down[i])
    return rmsnorm(h, final_norm)
```

```cpp
#include <hip/hip_runtime.h>
#include <hip/hip_cooperative_groups.h>
#include <cstdio>
#include <cstdint>
namespace cg = cooperative_groups;

#define LAS __attribute__((address_space(3)))
typedef unsigned short bf16_t;
typedef short bf16x8 __attribute__((ext_vector_type(8)));
typedef float f32x4 __attribute__((ext_vector_type(4)));
typedef float f32x2 __attribute__((ext_vector_type(2)));
typedef unsigned u32x4 __attribute__((ext_vector_type(4)));
typedef unsigned u32x2 __attribute__((ext_vector_type(2)));

constexpr int SEQ = 8192, DM = 2048, DFF = 5632, MEML = 256;
constexpr int NHEAD = 32, PW = 10240;
constexpr int PU0 = 0, PZ0 = 2048, PV0 = 4096, PX0 = 6144;
constexpr float EPS = 1e-6f;

constexpr size_t MiB = 1u << 20;
constexpr size_t WS_WGU1 = 1 * MiB, WS_WD1 = 45 * MiB, WS_WIN = 67 * MiB, WS_WOUTA = 108 * MiB, WS_WOUTM = 116 * MiB,
                 WS_WQ = 124 * MiB, WS_WKV = 132 * MiB, WS_WO = 148 * MiB, WS_WGU2 = 156 * MiB, WS_WD2 = 200 * MiB,
                 WS_XN = 222 * MiB, WS_P = 254 * MiB, WS_ST = 414 * MiB, WS_DT = 478 * MiB, WS_VPART = 479 * MiB,
                 WS_YPART = 480 * MiB, WS_CDEC = 481 * MiB, WS_KB = 482 * MiB, WS_VT = 483 * MiB, WS_MEMN = 484 * MiB,
                 WS_END = 485 * MiB;
constexpr size_t WS_ACT = WS_P;
constexpr size_t WS_Q = WS_P, WS_O = WS_P + 32 * MiB, WS_ACT2 = WS_P + 64 * MiB;

constexpr int LDS_BYTES = 147456;
#ifndef STOP_AFTER
#define STOP_AFTER 99
#endif

typedef __bf16 bf16x2_t __attribute__((ext_vector_type(2)));
__device__ __forceinline__ unsigned cvt_pk_bf16(float lo, float hi) { typedef float f2 __attribute__((ext_vector_type(2))); f2 v = {lo, hi}; bf16x2_t b = __builtin_convertvector(v, bf16x2_t); return __builtin_bit_cast(unsigned, b); }
__device__ __forceinline__ float bflo(unsigned u) { return __uint_as_float(u << 16); }
__device__ __forceinline__ float bfhi(unsigned u) { return __uint_as_float(u & 0xffff0000u); }
__device__ __forceinline__ float bf2f(unsigned short h) { return __uint_as_float(((unsigned)h) << 16); }
__device__ __forceinline__ float silu_f(float x) { return x * __builtin_amdgcn_rcpf(1.0f + __expf(-x)); }
__device__ __forceinline__ float gelu_f(float x) { const float y = 0.7978845608028654f * (x + 0.044715f * x * x * x); return x * __builtin_amdgcn_rcpf(1.0f + __expf(-2.0f * y)); }
__device__ __forceinline__ float wave_sum(float v) {
#pragma unroll
    for (int o = 1; o < 64; o <<= 1) v += __shfl_xor(v, o);
    return v;
}
__device__ __forceinline__ bf16x8 pack8(const float (&v)[8]) {
    u32x4 w; w.x = cvt_pk_bf16(v[0], v[1]); w.y = cvt_pk_bf16(v[2], v[3]); w.z = cvt_pk_bf16(v[4], v[5]); w.w = cvt_pk_bf16(v[6], v[7]);
    return __builtin_bit_cast(bf16x8, w);
}

namespace pg8 {
constexpr int BM = 256, BK = 64, HALF = 128, HTB = HALF * BK * 2, STAGE_BYTES = 8 * HTB, NXCD = 8, WGM = 8;
__host__ __device__ __forceinline__ int lds_byte(int r, int c) { const int st = (r >> 4) * 2 + (c >> 5), rr = r & 15, cc = c & 31, ob = rr * 64 + cc * 2; return st * 1024 + (ob ^ (((ob >> 9) & 1) << 5)); }
__host__ __device__ __forceinline__ void stage_rc(int b, int& R, int& C) { const int st = b / 1024, sb = b % 1024, swz = sb ^ (((sb >> 9) & 1) << 5); R = (st >> 1) * 16 + swz / 64; C = (st & 1) * 32 + (swz % 64) / 2; }
__host__ __device__ __forceinline__ int perm32(int rho) { const int n = rho >> 4, i = rho & 15; return 8 * (i >> 2) + 4 * n + (i & 3); }

struct Unit { int pm, pn; };
struct Gemm { const bf16_t* A; const bf16_t* Bt; int M, N, K, lda; };

struct StaticOrder {
    int nM, nN, nwg, G, c;
    __host__ __device__ void init(int M, int N, int G_, int c_) { nM = M / BM; nN = N / BM; nwg = nM * nN; G = G_; c = c_; }
    __host__ __device__ bool next(int i, Unit& u) const {
        const long L = (long)i * G + c; if (L >= nwg) return false;
        int wgid = (int)L; { const int q = nwg / NXCD, r = nwg % NXCD, xcd = wgid % NXCD, off = wgid / NXCD; wgid = (xcd < r ? xcd * (q + 1) : r * (q + 1) + (xcd - r) * q) + off; }
        const int nig = WGM * nN, gid = wgid / nig, fm = gid * WGM, gsz = (nM - fm) < WGM ? (nM - fm) : WGM;
        u.pm = fm + ((wgid % nig) % gsz); u.pn = (wgid % nig) / gsz; return true;
    }
};

template <class Epi, class Sched, bool ALIGN_EPI>
__device__ __forceinline__ void gemm_phase(LAS unsigned char* lds, const Gemm g, const Sched& S, const Epi& E) {
    const int tid = threadIdx.x, wid = __builtin_amdgcn_readfirstlane(tid >> 6), lane = tid & 63, wr = wid >> 2, wc = wid & 3, fr = lane & 15, fq = lane >> 4;
    const int K = g.K, nt = K / BK, lda = g.lda;
    unsigned voffA[2], voffB[2];
#pragma unroll
    for (int i = 0; i < 2; ++i) { int R, C; stage_rc(tid * 16 + i * 8192, R, C); const int Rb = Epi::PERM ? ((R & ~31) + perm32(R & 31)) : R;
        voffA[i] = (unsigned)(R * lda + C) * 2u; voffB[i] = (unsigned)(Rb * K + C) * 2u; }
    const size_t kstep = (size_t)(BK * 2);
    const size_t hstepA = (size_t)HALF * lda * 2, hstepB = (size_t)HALF * K * 2;
    const size_t tstepA = 2 * hstepA, tstepB = 2 * hstepB;
    const unsigned ldsw = (unsigned)wid * 1024u;
    const int aoff = lds_byte(wr * 64 + fr, fq * 8), boff = lds_byte(wc * 32 + fr, fq * 8);
#define PG8_SA(b, h) (((b) * 2 + (h)) * HTB)
#define PG8_SB(b, h) ((4 + (b) * 2 + (h)) * HTB)
#define PG8_STAGE(bufoff, gbase, voff) do { _Pragma("unroll") for (int _i = 0; _i < 2; ++_i) \
        __builtin_amdgcn_global_load_lds((const unsigned*)((const char*)(gbase) + (voff)[_i]), (LAS unsigned*)(lds + (bufoff) + ldsw + _i * 8192), 16, 0, 0); } while (0)
#define PG8_LDA(dst, b, h) do { _Pragma("unroll") for (int m = 0; m < 4; ++m) _Pragma("unroll") for (int k = 0; k < 2; ++k) dst[m][k] = *(const LAS bf16x8*)(lds + PG8_SA(b, h) + aoff + m * 2048 + k * 1024); } while (0)
#define PG8_LDB(dst, b, h) do { _Pragma("unroll") for (int n = 0; n < 2; ++n) _Pragma("unroll") for (int k = 0; k < 2; ++k) dst[n][k] = *(const LAS bf16x8*)(lds + PG8_SB(b, h) + boff + n * 2048 + k * 1024); } while (0)
#define PG8_MMA(ai, bj, At, Bt) do { __builtin_amdgcn_s_setprio(1); _Pragma("unroll") for (int m = 0; m < 4; ++m) _Pragma("unroll") for (int n = 0; n < 2; ++n) _Pragma("unroll") for (int k = 0; k < 2; ++k) \
        acc[ai][bj][m][n] = __builtin_amdgcn_mfma_f32_16x16x32_bf16(Bt[n][k], At[m][k], acc[ai][bj][m][n], 0, 0, 0); __builtin_amdgcn_s_setprio(0); } while (0)
#define PG8_WAIT_V(n) asm volatile("s_waitcnt vmcnt(" #n ")" ::: "memory")
#define PG8_WAIT_L(n) asm volatile("s_waitcnt lgkmcnt(" #n ")" ::: "memory")
#define PG8_BAR __builtin_amdgcn_s_barrier()
#define PG8_SCHED __builtin_amdgcn_sched_barrier(0)
    Unit cur, nxt; int ui = 0;
    if (!S.next(0, cur)) return;
    f32x4 acc[2][2][4][2];
#pragma unroll
    for (int a = 0; a < 2; ++a)
#pragma unroll
        for (int b = 0; b < 2; ++b)
#pragma unroll
            for (int m = 0; m < 4; ++m)
#pragma unroll
                for (int n = 0; n < 2; ++n) acc[a][b][m][n] = (f32x4){0.f, 0.f, 0.f, 0.f};
    bf16x8 At[4][2], B0[2][2], B1[2][2];
    const char* cA = (const char*)g.A + (size_t)cur.pm * tstepA; const char* cB = (const char*)g.Bt + (size_t)cur.pn * tstepB;
    PG8_STAGE(PG8_SB(0, 0), cB, voffB); PG8_STAGE(PG8_SB(0, 1), cB + hstepB, voffB); PG8_STAGE(PG8_SA(0, 0), cA, voffA); PG8_STAGE(PG8_SA(0, 1), cA + hstepA, voffA);
    if (wr == 1) PG8_BAR;
    PG8_WAIT_V(2); PG8_BAR;
    PG8_STAGE(PG8_SB(1, 0), cB + kstep, voffB); PG8_STAGE(PG8_SA(1, 0), cA + kstep, voffA); PG8_STAGE(PG8_SB(1, 1), cB + hstepB + kstep, voffB);
    PG8_WAIT_V(6); PG8_BAR;
    for (;;) {
        const bool has_next = S.next(ui + 1, nxt);
        const char* nA = has_next ? (const char*)g.A + (size_t)nxt.pm * tstepA : cA; const char* nB = has_next ? (const char*)g.Bt + (size_t)nxt.pn * tstepB : cB;
        for (int t = 0; t < nt; t += 2) {
            const bool last = (t == nt - 2);
            const char* a1 = cA + (size_t)(t + 1) * kstep;
            const char* a2 = last ? nA : cA + (size_t)(t + 2) * kstep; const char* b2 = last ? nB : cB + (size_t)(t + 2) * kstep;
            const char* a3 = a2 + kstep; const char* b3 = b2 + kstep;
            PG8_LDB(B0, 0, 0); PG8_LDB(B1, 0, 1); PG8_SCHED; PG8_LDA(At, 0, 0); PG8_STAGE(PG8_SA(1, 1), a1 + hstepA, voffA);
            PG8_WAIT_V(8); PG8_WAIT_L(0); PG8_BAR; PG8_MMA(0, 0, At, B0); PG8_MMA(0, 1, At, B1); PG8_BAR; PG8_SCHED;
            PG8_LDA(At, 0, 1); PG8_STAGE(PG8_SB(0, 0), b2, voffB); PG8_STAGE(PG8_SB(0, 1), b2 + hstepB, voffB); PG8_STAGE(PG8_SA(0, 0), a2, voffA);
            PG8_WAIT_V(8); PG8_WAIT_L(0); PG8_BAR; PG8_MMA(1, 0, At, B0); PG8_MMA(1, 1, At, B1); PG8_BAR; PG8_SCHED;
            PG8_LDB(B0, 1, 0); PG8_LDB(B1, 1, 1); PG8_SCHED; PG8_LDA(At, 1, 0); PG8_STAGE(PG8_SA(0, 1), a2 + hstepA, voffA);
            PG8_WAIT_V(8); PG8_WAIT_L(0); PG8_BAR; PG8_MMA(0, 0, At, B0); PG8_MMA(0, 1, At, B1); PG8_BAR; PG8_SCHED;
            PG8_LDA(At, 1, 1); PG8_STAGE(PG8_SB(1, 0), b3, voffB); PG8_STAGE(PG8_SB(1, 1), b3 + hstepB, voffB); PG8_STAGE(PG8_SA(1, 0), a3, voffA);
            PG8_WAIT_V(8); PG8_WAIT_L(0); PG8_BAR; PG8_MMA(1, 0, At, B0); PG8_MMA(1, 1, At, B1); PG8_BAR; PG8_SCHED;
        }
        if constexpr (ALIGN_EPI) { if (wr == 0) PG8_BAR; }
        E(acc, cur, wr, wc, fr, fq);
        if (!has_next) break;
#pragma unroll
        for (int a = 0; a < 2; ++a)
#pragma unroll
            for (int b = 0; b < 2; ++b)
#pragma unroll
                for (int m = 0; m < 4; ++m)
#pragma unroll
                    for (int n = 0; n < 2; ++n) acc[a][b][m][n] = (f32x4){0.f, 0.f, 0.f, 0.f};
        cur = nxt; cA = nA; cB = nB; ++ui;
        if constexpr (ALIGN_EPI) { if (wr == 1) PG8_BAR; }
    }
    PG8_WAIT_V(0);
    if constexpr (!ALIGN_EPI) { if (wr == 0) PG8_BAR; }
    PG8_BAR;
#undef PG8_SA
#undef PG8_SB
#undef PG8_STAGE
#undef PG8_LDA
#undef PG8_LDB
#undef PG8_MMA
#undef PG8_WAIT_V
#undef PG8_WAIT_L
#undef PG8_BAR
#undef PG8_SCHED
}

struct EpiSwiGLU {
    static constexpr bool PERM = true;
    bf16_t* O; int ldc;
    __device__ __forceinline__ void operator()(const f32x4 (&acc)[2][2][4][2], const Unit& u, int wr, int wc, int fr, int fq) const {
        const int row0 = u.pm * BM + wr * 64 + fr, col0 = u.pn * HALF + wc * 32 + 8 * fq;
#pragma unroll
        for (int ai = 0; ai < 2; ++ai)
#pragma unroll
            for (int m = 0; m < 4; ++m) {
                bf16_t* rowp = O + (size_t)(row0 + ai * HALF + m * 16) * ldc + col0;
                float v[8];
#pragma unroll
                for (int n = 0; n < 2; ++n)
#pragma unroll
                    for (int j = 0; j < 4; ++j) v[n * 4 + j] = silu_f(acc[ai][0][m][n][j]) * acc[ai][1][m][n][j];
                u32x4 w; w.x = cvt_pk_bf16(v[0], v[1]); w.y = cvt_pk_bf16(v[2], v[3]); w.z = cvt_pk_bf16(v[4], v[5]); w.w = cvt_pk_bf16(v[6], v[7]);
                *(u32x4*)rowp = w;
            }
    }
};
struct EpiResid {
    static constexpr bool PERM = false;
    const float* base; float* out; int ldc; float alpha; const float* part;
    __device__ __forceinline__ void operator()(const f32x4 (&acc)[2][2][4][2], const Unit& u, int wr, int wc, int fr, int fq) const {
        const int col0 = u.pn * BM + wc * 32 + 4 * fq;
#pragma unroll
        for (int ai = 0; ai < 2; ++ai)
#pragma unroll
            for (int m = 0; m < 4; ++m) {
                const int row = u.pm * BM + ai * HALF + wr * 64 + m * 16 + fr;
                float sc = alpha;
                if (part) { const f32x4 p0 = *(const f32x4*)(part + (size_t)row * 32 + fq * 8), p1 = *(const f32x4*)(part + (size_t)row * 32 + fq * 8 + 4);
                    float s = (p0[0] + p0[1]) + (p0[2] + p0[3]) + (p1[0] + p1[1]) + (p1[2] + p1[3]); s += __shfl_xor(s, 16); s += __shfl_xor(s, 32);
                    sc = alpha * rsqrtf(s * (1.0f / 2048.0f) + EPS); }
                const size_t off = (size_t)row * ldc + col0;
#pragma unroll
                for (int bj = 0; bj < 2; ++bj)
#pragma unroll
                    for (int n = 0; n < 2; ++n) { const f32x4 b = *(const f32x4*)(base + off + bj * HALF + n * 16); *(f32x4*)(out + off + bj * HALF + n * 16) = b + acc[ai][bj][m][n] * sc; }
            }
    }
};
struct EpiBf16 {
    static constexpr bool PERM = true;
    bf16_t* O; int ldc; float scale;
    __device__ __forceinline__ void operator()(const f32x4 (&acc)[2][2][4][2], const Unit& u, int wr, int wc, int fr, int fq) const {
        const int row0 = u.pm * BM + wr * 64 + fr, col0 = u.pn * BM + wc * 32 + 8 * fq;
#pragma unroll
        for (int ai = 0; ai < 2; ++ai)
#pragma unroll
            for (int m = 0; m < 4; ++m) { bf16_t* rowp = O + (size_t)(row0 + ai * HALF + m * 16) * ldc + col0;
#pragma unroll
                for (int bj = 0; bj < 2; ++bj) { const f32x4 v0 = acc[ai][bj][m][0] * scale, v1 = acc[ai][bj][m][1] * scale;
                    u32x4 w; w.x = cvt_pk_bf16(v0[0], v0[1]); w.y = cvt_pk_bf16(v0[2], v0[3]); w.z = cvt_pk_bf16(v1[0], v1[1]); w.w = cvt_pk_bf16(v1[2], v1[3]);
                    *(u32x4*)(rowp + bj * HALF) = w; } }
    }
};
struct EpiKV {
    static constexpr bool PERM = true;
    bf16_t* KB; bf16_t* VT;
    __device__ __forceinline__ void operator()(const f32x4 (&acc)[2][2][4][2], const Unit& u, int wr, int wc, int fr, int fq) const {
        const int row0 = u.pm * BM + wr * 64 + fr, col0 = u.pn * BM + wc * 32 + 8 * fq;
#pragma unroll
        for (int ai = 0; ai < 2; ++ai)
#pragma unroll
            for (int m = 0; m < 4; ++m) { const int row = row0 + ai * HALF + m * 16;
#pragma unroll
                for (int bj = 0; bj < 2; ++bj) { const int col = col0 + bj * HALF;
                    if (col < 2048) { const f32x4 v0 = acc[ai][bj][m][0], v1 = acc[ai][bj][m][1];
                        u32x4 w; w.x = cvt_pk_bf16(v0[0], v0[1]); w.y = cvt_pk_bf16(v0[2], v0[3]); w.z = cvt_pk_bf16(v1[0], v1[1]); w.w = cvt_pk_bf16(v1[2], v1[3]);
                        *(u32x4*)(KB + (size_t)row * 2048 + col) = w;
                    } else {
#pragma unroll
                        for (int n = 0; n < 2; ++n)
#pragma unroll
                            for (int j = 0; j < 4; ++j) VT[(size_t)(col - 2048 + n * 4 + j) * 256 + row] = (bf16_t)(cvt_pk_bf16(acc[ai][bj][m][n][j], 0.f) & 0xffffu);
                    } } }
    }
};
struct EpiWin {
    static constexpr bool PERM = true;
    bf16_t* P; float* dt; float* vpart;
    __device__ __forceinline__ void operator()(const f32x4 (&acc)[2][2][4][2], const Unit& u, int wr, int wc, int fr, int fq) const {
        const int pn = u.pn;
        const int row0 = u.pm * BM + wr * 64 + fr;
        if (pn == 40) {
            if (wc == 0) {
#pragma unroll
                for (int ai = 0; ai < 2; ++ai)
#pragma unroll
                    for (int m = 0; m < 4; ++m) { float* rp = dt + (size_t)(row0 + ai * HALF + m * 16) * 32 + 8 * fq;
                        *(f32x4*)rp = acc[ai][0][m][0]; *(f32x4*)(rp + 4) = acc[ai][0][m][1]; }
            }
            return;
        }
        const int mode = pn < 8 ? 0 : (pn < 16 ? 1 : (pn < 24 ? 2 : 3));
        const int col0 = pn * BM + wc * 32 + 8 * fq;
#pragma unroll
        for (int ai = 0; ai < 2; ++ai)
#pragma unroll
            for (int m = 0; m < 4; ++m) { const int row = row0 + ai * HALF + m * 16; bf16_t* rowp = P + (size_t)row * PW + col0; float ss = 0.f;
#pragma unroll
                for (int bj = 0; bj < 2; ++bj) { float v[8];
#pragma unroll
                    for (int n = 0; n < 2; ++n)
#pragma unroll
                        for (int j = 0; j < 4; ++j) { float x = acc[ai][bj][m][n][j];
                            if (mode == 0 || mode == 2) x = gelu_f(x); else if (mode == 1) x = silu_f(x);
                            v[n * 4 + j] = x; ss += x * x; }
                    u32x4 w; w.x = cvt_pk_bf16(v[0], v[1]); w.y = cvt_pk_bf16(v[2], v[3]); w.z = cvt_pk_bf16(v[4], v[5]); w.w = cvt_pk_bf16(v[6], v[7]);
                    *(u32x4*)(rowp + bj * HALF) = w; }
                if (mode == 2) { ss += __shfl_xor(ss, 16); ss += __shfl_xor(ss, 32); if (fq == 0) vpart[(size_t)row * 32 + (pn - 16) * 4 + wc] = ss; }
            }
    }
};
}

struct Args { const float* in[26]; float* out; unsigned char* ws; };

__device__ __forceinline__ int maprow(int mode, int n0) {
    if (mode == 1) { return n0 < DFF ? (n0 / 128) * 256 + (n0 % 128) : ((n0 - DFF) / 128) * 256 + 128 + ((n0 - DFF) % 128); }
    if (mode == 2) { return (n0 >= 2048 && n0 < 4096) ? n0 + 2048 : ((n0 >= 4096 && n0 < 6144) ? n0 - 2048 : n0); }
    return n0;
}
__device__ __forceinline__ void tr_item(const float* W, int K, int N, bf16_t* WT, int mode, LAS float* scr, int item, int lane) {
    const int nblk = N / 32, kb = item / nblk, nb = item % nblk, k0 = 64 * kb, n0 = 32 * nb;
    const int r0 = maprow(mode, n0);
#pragma unroll 8
    for (int i = 0; i < 32; ++i) { const int kk = 2 * i + (lane >> 5); scr[kk * 33 + (lane & 31)] = W[(size_t)(k0 + kk) * N + n0 + (lane & 31)]; }
    asm volatile("s_waitcnt lgkmcnt(0)" ::: "memory");
    const int c = lane & 7;
#pragma unroll
    for (int j = 0; j < 4; ++j) { const int n = (lane >> 3) + 8 * j; const LAS float* s = scr + (8 * c) * 33 + n;
        u32x4 o; o.x = cvt_pk_bf16(s[0 * 33], s[1 * 33]); o.y = cvt_pk_bf16(s[2 * 33], s[3 * 33]); o.z = cvt_pk_bf16(s[4 * 33], s[5 * 33]); o.w = cvt_pk_bf16(s[6 * 33], s[7 * 33]);
        *(u32x4*)(WT + (size_t)(r0 + n) * K + k0 + 8 * c) = o; }
    asm volatile("s_waitcnt lgkmcnt(0)" ::: "memory");
}
__device__ __forceinline__ void norm_row_bf16(const float* xrow, const float* w, bf16_t* orow, int lane) {
    const f32x4* xr = (const f32x4*)xrow + lane; const f32x4* wr = (const f32x4*)w + lane;
    f32x4 v[8]; float s = 0.f;
#pragma unroll
    for (int j = 0; j < 8; ++j) { v[j] = xr[64 * j]; s += (v[j].x * v[j].x + v[j].y * v[j].y) + (v[j].z * v[j].z + v[j].w * v[j].w); }
    const float rstd = rsqrtf(wave_sum(s) * (1.f / 2048.f) + EPS);
    u32x2* o8 = (u32x2*)orow + lane;
#pragma unroll
    for (int j = 0; j < 8; ++j) { const f32x4 ww = wr[64 * j]; u32x2 o; o.x = cvt_pk_bf16(v[j].x * rstd * ww.x, v[j].y * rstd * ww.y); o.y = cvt_pk_bf16(v[j].z * rstd * ww.z, v[j].w * rstd * ww.w); o8[64 * j] = o; }
}
__device__ __forceinline__ void norm_row_f32(const float* xrow, const float* w, float* orow, int lane) {
    const f32x4* xr = (const f32x4*)xrow + lane; const f32x4* wr = (const f32x4*)w + lane;
    f32x4 v[8]; float s = 0.f;
#pragma unroll
    for (int j = 0; j < 8; ++j) { v[j] = xr[64 * j]; s += (v[j].x * v[j].x + v[j].y * v[j].y) + (v[j].z * v[j].z + v[j].w * v[j].w); }
    const float rstd = rsqrtf(wave_sum(s) * (1.f / 2048.f) + EPS);
    f32x4* o = (f32x4*)orow + lane;
#pragma unroll
    for (int j = 0; j < 8; ++j) { const f32x4 ww = wr[64 * j]; o[64 * j] = v[j] * rstd * ww; }
}

constexpr int LP = 272;
__device__ __forceinline__ void conv8(const bf16_t* P, int tok, int col, int ch, const float* cw, const float* cb, float (&o)[8]) {
    const f32x4 b0 = *(const f32x4*)(cb + ch), b1 = *(const f32x4*)(cb + ch + 4);
    float a[8] = {b0[0], b0[1], b0[2], b0[3], b1[0], b1[1], b1[2], b1[3]};
#pragma unroll
    for (int k = 0; k < 4; ++k) { const int r = tok - 3 + k;
        if (r >= 0) { const u32x4 raw = *(const u32x4*)(P + (size_t)r * PW + col);
            const f32x4 w0 = *(const f32x4*)(cw + k * 4096 + ch), w1 = *(const f32x4*)(cw + k * 4096 + ch + 4);
            a[0] += bflo(raw.x) * w0[0]; a[1] += bfhi(raw.x) * w0[1]; a[2] += bflo(raw.y) * w0[2]; a[3] += bfhi(raw.y) * w0[3];
            a[4] += bflo(raw.z) * w1[0]; a[5] += bfhi(raw.z) * w1[1]; a[6] += bflo(raw.w) * w1[2]; a[7] += bfhi(raw.w) * w1[3]; } }
#pragma unroll
    for (int i = 0; i < 8; ++i) o[i] = silu_f(a[i]);
}
__device__ __forceinline__ float softplus_f(float x) { return x > 20.f ? x : log1pf(expf(x)); }
__device__ __forceinline__ void dt_cum(const float* dtraw, int tok0, int h, const float* dt_bias, const float* a_log, LAS float* dtv, LAS float* cum, int lane) {
    const float bias = dt_bias[h], a = -expf(a_log[h]);
    const int l0 = 2 * lane;
    const float d0 = softplus_f(dtraw[(size_t)(tok0 + l0) * 32 + h] + bias), d1 = softplus_f(dtraw[(size_t)(tok0 + l0 + 1) * 32 + h] + bias);
    const float s0 = d0 * a, s1 = s0 + d1 * a;
    float incl = s1;
#pragma unroll
    for (int o = 1; o < 64; o <<= 1) { const float t = __shfl_up(incl, o); if (lane >= o) incl += t; }
    const float excl = incl - s1;
    cum[l0] = excl + s0; cum[l0 + 1] = incl; dtv[l0] = d0; dtv[l0 + 1] = d1;
}
#define GRID_SYNC() do { asm volatile("s_waitcnt vmcnt(0) lgkmcnt(0)" ::: "memory"); __syncthreads(); grid.sync(); __builtin_amdgcn_fence(__ATOMIC_ACQUIRE, "agent"); asm volatile("s_waitcnt vmcnt(0)" ::: "memory"); __syncthreads(); } while (0)
#define MFMA16(a, b, c) __builtin_amdgcn_mfma_f32_16x16x32_bf16((a), (b), (c), 0, 0, 0)

__global__ void __launch_bounds__(512, 2) mega_fwd(Args args) {
    extern __shared__ __attribute__((aligned(16))) unsigned char lds_raw[];
    LAS unsigned char* lds = (LAS unsigned char*)lds_raw;
    cg::grid_group grid = cg::this_grid();
    const int tid = threadIdx.x, lane = tid & 63, wave = __builtin_amdgcn_readfirstlane(tid >> 6);
    const int G = gridDim.x, bid = blockIdx.x;
    const int gw = bid * 8 + wave, NGW = G * 8;
    const int fr = lane & 15, fq = lane >> 4;
    unsigned char* ws = args.ws;
    const float* x = args.in[0];
    float* H = args.out;
    bf16_t* WGU1 = (bf16_t*)(ws + WS_WGU1); bf16_t* WD1 = (bf16_t*)(ws + WS_WD1); bf16_t* WIN = (bf16_t*)(ws + WS_WIN);
    bf16_t* WOUTA = (bf16_t*)(ws + WS_WOUTA); bf16_t* WOUTM = (bf16_t*)(ws + WS_WOUTM); bf16_t* WQ = (bf16_t*)(ws + WS_WQ);
    bf16_t* WKV = (bf16_t*)(ws + WS_WKV); bf16_t* WO = (bf16_t*)(ws + WS_WO); bf16_t* WGU2 = (bf16_t*)(ws + WS_WGU2); bf16_t* WD2 = (bf16_t*)(ws + WS_WD2);
    bf16_t* XN = (bf16_t*)(ws + WS_XN); bf16_t* P = (bf16_t*)(ws + WS_P); bf16_t* ACT = (bf16_t*)(ws + WS_ACT); bf16_t* ACT2 = (bf16_t*)(ws + WS_ACT2);
    bf16_t* QB = (bf16_t*)(ws + WS_Q); bf16_t* OB = (bf16_t*)(ws + WS_O);
    float* ST = (float*)(ws + WS_ST); float* DT = (float*)(ws + WS_DT); float* VPART = (float*)(ws + WS_VPART); float* YPART = (float*)(ws + WS_YPART);
    float* CDEC = (float*)(ws + WS_CDEC); bf16_t* KB = (bf16_t*)(ws + WS_KB); bf16_t* VT = (bf16_t*)(ws + WS_VT); bf16_t* MEMN = (bf16_t*)(ws + WS_MEMN);

    {
        LAS float* scr = (LAS float*)(lds + wave * 16384);
        constexpr int I_GU = 32 * 352, I_DN = 88 * 64, I_WIN = 32 * 321, I_SQ = 32 * 64, I_KV = 32 * 128;
        constexpr int NITEMS = 2 * I_GU + 2 * I_DN + I_WIN + 4 * I_SQ + I_KV;
        for (int it = gw; it < NITEMS; it += NGW) {
            int r = it;
            if (r < I_GU) { tr_item(args.in[3], DM, 2 * DFF, WGU1, 1, scr, r, lane); continue; } r -= I_GU;
            if (r < I_DN) { tr_item(args.in[4], DFF, DM, WD1, 0, scr, r, lane); continue; } r -= I_DN;
            if (r < I_WIN) { tr_item(args.in[6], DM, 10272, WIN, 2, scr, r, lane); continue; } r -= I_WIN;
            if (r < I_SQ) { tr_item(args.in[16], DM, DM, WOUTA, 0, scr, r, lane); continue; } r -= I_SQ;
            if (r < I_SQ) { tr_item(args.in[16] + (size_t)2048 * 2048, DM, DM, WOUTM, 0, scr, r, lane); continue; } r -= I_SQ;
            if (r < I_SQ) { tr_item(args.in[19], DM, DM, WQ, 0, scr, r, lane); continue; } r -= I_SQ;
            if (r < I_KV) { tr_item(args.in[20], DM, 2 * DM, WKV, 0, scr, r, lane); continue; } r -= I_KV;
            if (r < I_SQ) { tr_item(args.in[21], DM, DM, WO, 0, scr, r, lane); continue; } r -= I_SQ;
            if (r < I_GU) { tr_item(args.in[23], DM, 2 * DFF, WGU2, 1, scr, r, lane); continue; } r -= I_GU;
            tr_item(args.in[24], DFF, DM, WD2, 0, scr, r, lane);
        }
        for (int m = gw; m < SEQ + MEML; m += NGW) {
            if (m < SEQ) norm_row_bf16(x + (size_t)m * DM, args.in[2], XN + (size_t)m * DM, lane);
            else norm_row_bf16(args.in[1] + (size_t)(m - SEQ) * DM, args.in[18], MEMN + (size_t)(m - SEQ) * DM, lane);
        }
    }
    GRID_SYNC();

    {
        pg8::Gemm g{XN, WGU1, SEQ, 2 * DFF, DM, DM}; pg8::StaticOrder S; S.init(SEQ, 2 * DFF, G, bid);
        pg8::EpiSwiGLU E{ACT, DFF};
        pg8::gemm_phase<pg8::EpiSwiGLU, pg8::StaticOrder, true>(lds, g, S, E);
        pg8::Gemm g2{MEMN, WKV, MEML, 2 * DM, DM, DM}; pg8::StaticOrder S2; S2.init(MEML, 2 * DM, G, (bid + G - (G / 2)) % G);
        pg8::EpiKV E2{KB, VT};
        pg8::gemm_phase<pg8::EpiKV, pg8::StaticOrder, true>(lds, g2, S2, E2);
    }
    GRID_SYNC();

    {
        pg8::Gemm g{ACT, WD1, SEQ, DM, DFF, DFF}; pg8::StaticOrder S; S.init(SEQ, DM, G, bid);
        pg8::EpiResid E{x, H, DM, 0.5f, nullptr};
        pg8::gemm_phase<pg8::EpiResid, pg8::StaticOrder, true>(lds, g, S, E);
    }
    GRID_SYNC();

    if (STOP_AFTER >= 3) {
    for (int m = gw; m < SEQ; m += NGW) norm_row_bf16(H + (size_t)m * DM, args.in[5], XN + (size_t)m * DM, lane);
    GRID_SYNC();

    if (STOP_AFTER >= 4) {
    {
        pg8::Gemm g{XN, WIN, SEQ, 41 * 256, DM, DM}; pg8::StaticOrder S; S.init(SEQ, 41 * 256, G, bid);
        pg8::EpiWin E{P, DT, VPART};
        pg8::gemm_phase<pg8::EpiWin, pg8::StaticOrder, true>(lds, g, S, E);
    }
    GRID_SYNC();

    if (STOP_AFTER >= 5) {
    const float* conv_w = args.in[10]; const float* conv_b = args.in[11];
    {
        constexpr int XT_OFF = 0, BP_OFF = 64 * LP, SC_OFF = BP_OFF + 128 * LP;
        LAS float* dtv = (LAS float*)(lds + SC_OFF); LAS float* cum = dtv + 128;
        for (int unit = bid; unit < 64 * NHEAD; unit += G) {
            const int c = unit >> 5, h = unit & 31, g = h >> 2, tok0 = c * 128;
            __syncthreads();
            if (wave == 0) dt_cum(DT, tok0, h, args.in[12], args.in[13], dtv, cum, lane);
            for (int i = tid; i < 128 * 8; i += 512) { const int l = i >> 3, p8 = (i & 7) * 8; float o[8];
                conv8(P, tok0 + l, PX0 + h * 64 + p8, h * 64 + p8, conv_w, conv_b, o);
#pragma unroll
                for (int q = 0; q < 8; ++q) *(LAS unsigned short*)(lds + XT_OFF + (p8 + q) * LP + l * 2) = (unsigned short)(cvt_pk_bf16(o[q], 0.f) & 0xffffu); }
            for (int i = tid; i < 128 * 16; i += 512) { const int l = i >> 4, n8 = (i & 15) * 8; float o[8];
                conv8(P, tok0 + l, PX0 + 2048 + g * 128 + n8, 2048 + g * 128 + n8, conv_w, conv_b, o);
                *(LAS bf16x8*)(lds + BP_OFF + l * LP + n8 * 2) = pack8(o); }
            __syncthreads();
            const float cl = cum[127];
            if (tid == 0) CDEC[c * 32 + h] = expf(cl);
            bf16x8 bfr[4];
#pragma unroll
            for (int kk = 0; kk < 4; ++kk) { bf16x8 t;
#pragma unroll
                for (int j = 0; j < 8; ++j) t[j] = (short)*(LAS unsigned short*)(lds + BP_OFF + (kk * 32 + fq * 8 + j) * LP + (16 * wave + fr) * 2);
                bfr[kk] = t; }
            float wl[4][8];
#pragma unroll
            for (int kk = 0; kk < 4; ++kk)
#pragma unroll
                for (int j = 0; j < 8; ++j) { const int l = kk * 32 + fq * 8 + j; wl[kk][j] = dtv[l] * __expf(cl - cum[l]); }
            float* stp = ST + ((size_t)(c * 32 + h) * 64) * 128;
#pragma unroll
            for (int pt = 0; pt < 4; ++pt) { f32x4 acc = {0.f, 0.f, 0.f, 0.f};
#pragma unroll
                for (int kk = 0; kk < 4; ++kk) { const bf16x8 raw = *(LAS bf16x8*)(lds + XT_OFF + (pt * 16 + fr) * LP + (kk * 32 + fq * 8) * 2); float v[8];
#pragma unroll
                    for (int j = 0; j < 8; ++j) v[j] = bf2f((unsigned short)raw[j]) * wl[kk][j];
                    acc = MFMA16(pack8(v), bfr[kk], acc); }
#pragma unroll
                for (int j = 0; j < 4; ++j) stp[(size_t)(pt * 16 + fq * 4 + j) * 128 + 16 * wave + fr] = acc[j]; }
        }
    }
    {
        constexpr int GV_OFF = 0, AM_OFF = 128 * LP, RS_OFF = 2 * 128 * LP;
        LAS float* rs = (LAS float*)(lds + RS_OFF);
        const float* w_s = args.in[8]; const float* b_s = args.in[9]; const float* vnw = args.in[7];
        for (int unit = bid; unit < 64 * 16; unit += G) {
            const int c = unit >> 4, g = (unit >> 2) & 3, dq = unit & 3, tok0 = c * 128, ch0 = g * 512 + dq * 128;
            __syncthreads();
            if (tid < 128) { const f32x4* pp = (const f32x4*)(VPART + (size_t)(tok0 + tid) * 32); float s = 0.f;
#pragma unroll
                for (int q = 0; q < 8; ++q) { const f32x4 t = pp[q]; s += (t[0] + t[1]) + (t[2] + t[3]); }
                rs[tid] = rsqrtf(s * (1.f / 2048.f) + EPS); }
            for (int i = tid; i < 128 * 16; i += 512) { const int s = i >> 4, d8 = (i & 15) * 8;
                const u32x4 raw = *(const u32x4*)(P + (size_t)(tok0 + s) * PW + PV0 + ch0 + d8);
                LAS unsigned char* dst = lds + GV_OFF + d8 * LP + s * 2;
                *(LAS unsigned short*)(dst + 0 * LP) = (unsigned short)(raw.x & 0xffffu); *(LAS unsigned short*)(dst + 1 * LP) = (unsigned short)(raw.x >> 16);
                *(LAS unsigned short*)(dst + 2 * LP) = (unsigned short)(raw.y & 0xffffu); *(LAS unsigned short*)(dst + 3 * LP) = (unsigned short)(raw.y >> 16);
                *(LAS unsigned short*)(dst + 4 * LP) = (unsigned short)(raw.z & 0xffffu); *(LAS unsigned short*)(dst + 5 * LP) = (unsigned short)(raw.z >> 16);
                *(LAS unsigned short*)(dst + 6 * LP) = (unsigned short)(raw.w & 0xffffu); *(LAS unsigned short*)(dst + 7 * LP) = (unsigned short)(raw.w >> 16); }
            __syncthreads();
            for (int i = tid; i < 128 * 16; i += 512) { const int t = i >> 4, s8 = (i & 15) * 8;
                const f32x4 w0 = *(const f32x4*)(w_s + ((size_t)g * 128 + t) * 128 + s8), w1 = *(const f32x4*)(w_s + ((size_t)g * 128 + t) * 128 + s8 + 4);
                float v[8] = {w0[0], w0[1], w0[2], w0[3], w1[0], w1[1], w1[2], w1[3]};
#pragma unroll
                for (int q = 0; q < 8; ++q) v[q] = (s8 + q <= t) ? v[q] * rs[s8 + q] : 0.f;
                *(LAS bf16x8*)(lds + AM_OFF + t * LP + s8 * 2) = pack8(v); }
            __syncthreads();
            bf16x8 afr[4];
#pragma unroll
            for (int kk = 0; kk < 4; ++kk) afr[kk] = *(LAS bf16x8*)(lds + GV_OFF + (16 * wave + fr) * LP + (kk * 32 + fq * 8) * 2);
            const f32x4 wv = *(const f32x4*)(vnw + ch0 + 16 * wave + fq * 4);
#pragma unroll
            for (int tt = 0; tt < 8; ++tt) { f32x4 acc = {0.f, 0.f, 0.f, 0.f};
#pragma unroll
                for (int kk = 0; kk < 4; ++kk) { const bf16x8 b = *(LAS bf16x8*)(lds + AM_OFF + (tt * 16 + fr) * LP + (kk * 32 + fq * 8) * 2); acc = MFMA16(afr[kk], b, acc); }
                const int t = tt * 16 + fr; const float bb = b_s[g * 128 + t];
                bf16_t* up = P + (size_t)(tok0 + t) * PW + PU0 + ch0 + 16 * wave + fq * 4;
                const u32x2 uu = *(const u32x2*)up;
                u32x2 o; o.x = cvt_pk_bf16(bflo(uu.x) * (acc[0] * wv[0] + bb), bfhi(uu.x) * (acc[1] * wv[1] + bb)); o.y = cvt_pk_bf16(bflo(uu.y) * (acc[2] * wv[2] + bb), bfhi(uu.y) * (acc[3] * wv[3] + bb));
                *(u32x2*)up = o; }
        }
    }
    GRID_SYNC();

    if (STOP_AFTER >= 6) {
    {
        for (int e = bid * 512 + tid; e < NHEAD * 64 * 128 / 4; e += G * 512) {
            const int h = e / (64 * 128 / 4);
            f32x4 carry = {0.f, 0.f, 0.f, 0.f};
            f32x4* p = (f32x4*)ST + e;
#pragma unroll 8
            for (int c = 0; c < 64; ++c) { const f32x4 v = p[(size_t)c * (NHEAD * 64 * 128 / 4)]; const float d = CDEC[c * 32 + h]; p[(size_t)c * (NHEAD * 64 * 128 / 4)] = carry; carry = carry * d + v; }
        }
    }
    GRID_SYNC();

    if (STOP_AFTER >= 7) {
    {
        constexpr int XT_OFF = 0, BP_OFF = 64 * LP, CP_OFF = BP_OFF + 128 * LP, MM_OFF = CP_OFF + 128 * LP, SC_OFF = MM_OFF + 128 * LP;
        LAS float* dtv = (LAS float*)(lds + SC_OFF); LAS float* cum = dtv + 128;
        const float* dskip = args.in[14]; const float* snw = args.in[15];
        for (int unit = bid; unit < 64 * NHEAD; unit += G) {
            const int c = unit >> 5, h = unit & 31, g = h >> 2, tok0 = c * 128;
            __syncthreads();
            if (wave == 0) dt_cum(DT, tok0, h, args.in[12], args.in[13], dtv, cum, lane);
            for (int i = tid; i < 128 * 8; i += 512) { const int l = i >> 3, p8 = (i & 7) * 8; float o[8];
                conv8(P, tok0 + l, PX0 + h * 64 + p8, h * 64 + p8, conv_w, conv_b, o);
#pragma unroll
                for (int q = 0; q < 8; ++q) *(LAS unsigned short*)(lds + XT_OFF + (p8 + q) * LP + l * 2) = (unsigned short)(cvt_pk_bf16(o[q], 0.f) & 0xffffu); }
            for (int i = tid; i < 128 * 32; i += 512) { const int l = i >> 5, n8 = (i & 31) * 8; float o[8];
                conv8(P, tok0 + l, PX0 + 2048 + (n8 < 128 ? g * 128 + n8 : 1024 + g * 128 + n8 - 128), 2048 + (n8 < 128 ? g * 128 + n8 : 1024 + g * 128 + n8 - 128), conv_w, conv_b, o);
                *(LAS bf16x8*)(lds + (n8 < 128 ? BP_OFF + l * LP + n8 * 2 : CP_OFF + l * LP + (n8 - 128) * 2)) = pack8(o); }
            __syncthreads();
            bf16x8 cfr[4];
#pragma unroll
            for (int kk = 0; kk < 4; ++kk) cfr[kk] = *(LAS bf16x8*)(lds + CP_OFF + (16 * wave + fr) * LP + (kk * 32 + fq * 8) * 2);
            const int l = 16 * wave + fr; const float cl = cum[l];
#pragma unroll
            for (int st = 0; st < 8; ++st) { f32x4 acc = {0.f, 0.f, 0.f, 0.f};
#pragma unroll
                for (int kk = 0; kk < 4; ++kk) { const bf16x8 a = *(LAS bf16x8*)(lds + BP_OFF + (st * 16 + fr) * LP + (kk * 32 + fq * 8) * 2); acc = MFMA16(a, cfr[kk], acc); }
                float mv[4];
#pragma unroll
                for (int j = 0; j < 4; ++j) { const int s = st * 16 + fq * 4 + j; mv[j] = (s <= l) ? acc[j] * __expf(cl - cum[s]) * dtv[s] : 0.f; }
                u32x2 o; o.x = cvt_pk_bf16(mv[0], mv[1]); o.y = cvt_pk_bf16(mv[2], mv[3]);
                *(LAS u32x2*)(lds + MM_OFF + l * LP + (st * 16 + fq * 4) * 2) = o; }
            asm volatile("s_waitcnt lgkmcnt(0)" ::: "memory");
            bf16x8 mfr[4];
#pragma unroll
            for (int kk = 0; kk < 4; ++kk) mfr[kk] = *(LAS bf16x8*)(lds + MM_OFF + l * LP + (kk * 32 + fq * 8) * 2);
            const float ecl = __expf(cl), dsk = dskip[h];
            const float* prev = ST + ((size_t)(c * 32 + h) * 64) * 128;
            const int tok = tok0 + l;
            float ss = 0.f;
#pragma unroll
            for (int pt = 0; pt < 4; ++pt) { f32x4 ad = {0.f, 0.f, 0.f, 0.f}, ao = {0.f, 0.f, 0.f, 0.f};
#pragma unroll
                for (int kk = 0; kk < 4; ++kk) { const bf16x8 a = *(LAS bf16x8*)(lds + XT_OFF + (pt * 16 + fr) * LP + (kk * 32 + fq * 8) * 2); ad = MFMA16(a, mfr[kk], ad);
                    const f32x4 p0 = *(const f32x4*)(prev + (size_t)(pt * 16 + fr) * 128 + kk * 32 + fq * 8), p1 = *(const f32x4*)(prev + (size_t)(pt * 16 + fr) * 128 + kk * 32 + fq * 8 + 4);
                    float pv[8] = {p0[0], p0[1], p0[2], p0[3], p1[0], p1[1], p1[2], p1[3]};
                    ao = MFMA16(pack8(pv), cfr[kk], ao); }
                const int p0i = pt * 16 + fq * 4;
                bf16_t* zp = P + (size_t)tok * PW + PZ0 + h * 64 + p0i;
                const u32x2 zz = *(const u32x2*)zp; const float zf[4] = {bflo(zz.x), bfhi(zz.x), bflo(zz.y), bfhi(zz.y)};
                const f32x4 nw = *(const f32x4*)(snw + h * 64 + p0i);
                float yv[4];
#pragma unroll
                for (int j = 0; j < 4; ++j) { const float xv = bf2f(*(LAS unsigned short*)(lds + XT_OFF + (p0i + j) * LP + l * 2));
                    const float y = (ad[j] + ecl * ao[j] + dsk * xv) * zf[j]; ss += y * y; yv[j] = y * nw[j]; }
                u32x2 o; o.x = cvt_pk_bf16(yv[0], yv[1]); o.y = cvt_pk_bf16(yv[2], yv[3]);
                *(u32x2*)zp = o; }
            ss += __shfl_xor(ss, 16); ss += __shfl_xor(ss, 32);
            if (fq == 0) YPART[(size_t)tok * 32 + h] = ss;
        }
    }
    GRID_SYNC();

    if (STOP_AFTER >= 8) {
    {
        pg8::StaticOrder S; S.init(SEQ, DM, G, bid);
        pg8::Gemm g1{P + PU0, WOUTA, SEQ, DM, DM, PW};
        pg8::EpiResid E1{H, H, DM, 1.0f, nullptr};
        pg8::gemm_phase<pg8::EpiResid, pg8::StaticOrder, true>(lds, g1, S, E1);
        pg8::Gemm g2{P + PZ0, WOUTM, SEQ, DM, DM, PW};
        pg8::EpiResid E2{H, H, DM, 1.0f, YPART};
        pg8::gemm_phase<pg8::EpiResid, pg8::StaticOrder, true>(lds, g2, S, E2);
    }
    GRID_SYNC();

    if (STOP_AFTER >= 9) {
    for (int m = gw; m < SEQ; m += NGW) norm_row_bf16(H + (size_t)m * DM, args.in[17], XN + (size_t)m * DM, lane);
    GRID_SYNC();

    if (STOP_AFTER >= 10) {
    {
        pg8::Gemm g{XN, WQ, SEQ, DM, DM, DM}; pg8::StaticOrder S; S.init(SEQ, DM, G, bid);
        pg8::EpiBf16 E{QB, DM, 0.044194173824159216f};
        pg8::gemm_phase<pg8::EpiBf16, pg8::StaticOrder, true>(lds, g, S, E);
    }
    GRID_SYNC();

    if (STOP_AFTER >= 11) {
    {
        constexpr int PP = 528;
        LAS unsigned char* pw = lds + wave * 8448;
        for (int unit = bid; unit < 64 * 4; unit += G) {
            const int tb = unit >> 2, h = unit & 3, t0 = tb * 128 + 16 * wave;
            __syncthreads();
            bf16x8 qf[16];
#pragma unroll
            for (int kk = 0; kk < 16; ++kk) qf[kk] = *(const bf16x8*)(QB + (size_t)(t0 + fr) * DM + h * 512 + kk * 32 + fq * 8);
            f32x4 sacc[16];
#pragma unroll
            for (int mt = 0; mt < 16; ++mt) { f32x4 acc = {0.f, 0.f, 0.f, 0.f};
#pragma unroll
                for (int kk = 0; kk < 16; ++kk) { const bf16x8 a = *(const bf16x8*)(KB + (size_t)(mt * 16 + fr) * DM + h * 512 + kk * 32 + fq * 8); acc = MFMA16(a, qf[kk], acc); }
                sacc[mt] = acc; }
            float mx = -3.0e38f;
#pragma unroll
            for (int mt = 0; mt < 16; ++mt)
#pragma unroll
                for (int j = 0; j < 4; ++j) mx = fmaxf(mx, sacc[mt][j]);
            mx = fmaxf(mx, __shfl_xor(mx, 16)); mx = fmaxf(mx, __shfl_xor(mx, 32));
            float sum = 0.f;
#pragma unroll
            for (int mt = 0; mt < 16; ++mt)
#pragma unroll
                for (int j = 0; j < 4; ++j) { const float e = __expf(sacc[mt][j] - mx); sacc[mt][j] = e; sum += e; }
            sum += __shfl_xor(sum, 16); sum += __shfl_xor(sum, 32);
            const float inv = 1.0f / sum;
#pragma unroll
            for (int mt = 0; mt < 16; ++mt) { u32x2 o; o.x = cvt_pk_bf16(sacc[mt][0] * inv, sacc[mt][1] * inv); o.y = cvt_pk_bf16(sacc[mt][2] * inv, sacc[mt][3] * inv);
                *(LAS u32x2*)(pw + fr * PP + (mt * 16 + fq * 4) * 2) = o; }
            asm volatile("s_waitcnt lgkmcnt(0)" ::: "memory");
            bf16x8 pf[8];
#pragma unroll
            for (int kk = 0; kk < 8; ++kk) pf[kk] = *(LAS bf16x8*)(pw + fr * PP + (kk * 32 + fq * 8) * 2);
#pragma unroll
            for (int dt = 0; dt < 32; ++dt) { f32x4 acc = {0.f, 0.f, 0.f, 0.f};
#pragma unroll
                for (int kk = 0; kk < 8; ++kk) { const bf16x8 a = *(const bf16x8*)(VT + (size_t)(h * 512 + dt * 16 + fr) * 256 + kk * 32 + fq * 8); acc = MFMA16(a, pf[kk], acc); }
                u32x2 o; o.x = cvt_pk_bf16(acc[0], acc[1]); o.y = cvt_pk_bf16(acc[2], acc[3]);
                *(u32x2*)(OB + (size_t)(t0 + fr) * DM + h * 512 + dt * 16 + fq * 4) = o; }
        }
    }
    GRID_SYNC();

    if (STOP_AFTER >= 12) {
    {
        pg8::Gemm g{OB, WO, SEQ, DM, DM, DM}; pg8::StaticOrder S; S.init(SEQ, DM, G, bid);
        pg8::EpiResid E{H, H, DM, 1.0f, nullptr};
        pg8::gemm_phase<pg8::EpiResid, pg8::StaticOrder, true>(lds, g, S, E);
    }
    GRID_SYNC();

    if (STOP_AFTER >= 13) {
    for (int m = gw; m < SEQ; m += NGW) norm_row_bf16(H + (size_t)m * DM, args.in[22], XN + (size_t)m * DM, lane);
    GRID_SYNC();

    if (STOP_AFTER >= 14) {
    {
        pg8::Gemm g{XN, WGU2, SEQ, 2 * DFF, DM, DM}; pg8::StaticOrder S; S.init(SEQ, 2 * DFF, G, bid);
        pg8::EpiSwiGLU E{ACT2, DFF};
        pg8::gemm_phase<pg8::EpiSwiGLU, pg8::StaticOrder, true>(lds, g, S, E);
    }
    GRID_SYNC();

    if (STOP_AFTER >= 15) {
    {
        pg8::Gemm g{ACT2, WD2, SEQ, DM, DFF, DFF}; pg8::StaticOrder S; S.init(SEQ, DM, G, bid);
        pg8::EpiResid E{H, H, DM, 0.5f, nullptr};
        pg8::gemm_phase<pg8::EpiResid, pg8::StaticOrder, true>(lds, g, S, E);
    }
    GRID_SYNC();

    }}}}}}}}}}}}}
    for (int m = gw; m < SEQ; m += NGW) norm_row_f32(H + (size_t)m * DM, args.in[25], H + (size_t)m * DM, lane);
}

extern "C" void kernel_launch(void* const* d_in, const int* in_sizes, int n_in, void* d_out, int out_size, void* d_ws, size_t ws_size, hipStream_t stream) {
    static int grid = 0;
    if (grid == 0) {
        if (n_in != 26 || out_size != SEQ * DM || ws_size < WS_END) { fprintf(stderr, "kernel_launch: unexpected shapes (n_in %d out %d ws %zu)\n", n_in, out_size, ws_size); grid = -1; return; }
        int dev = 0, cus = 0, per_cu = 0;
        if (hipGetDevice(&dev) != hipSuccess || hipDeviceGetAttribute(&cus, hipDeviceAttributeMultiprocessorCount, dev) != hipSuccess) { grid = -1; return; }
        if (hipFuncSetAttribute((const void*)mega_fwd, hipFuncAttributeMaxDynamicSharedMemorySize, LDS_BYTES) != hipSuccess) { fprintf(stderr, "kernel_launch: hipFuncSetAttribute failed\n"); grid = -1; return; }
        if (hipOccupancyMaxActiveBlocksPerMultiprocessor(&per_cu, (const void*)mega_fwd, 512, LDS_BYTES) != hipSuccess || per_cu < 1) { fprintf(stderr, "kernel_launch: occupancy query failed (%d)\n", per_cu); (void)hipGetLastError(); per_cu = 1; }
        grid = cus * (per_cu < 1 ? 1 : 1);
    }
    if (grid < 0) return;
    Args a{};
    for (int i = 0; i < 26; ++i) a.in[i] = (const float*)d_in[i];
    a.out = (float*)d_out; a.ws = (unsigned char*)d_ws;
    void* kargs[] = {&a};
    hipError_t e = hipLaunchCooperativeKernel((const void*)mega_fwd, dim3(grid), dim3(512), kargs, LDS_BYTES, stream);
    if (e != hipSuccess) fprintf(stderr, "cooperative launch failed: %s (grid %d)\n", hipGetErrorString(e), grid);
}
```

```cpp
#include <hip/hip_runtime.h>
#include <hip/hip_cooperative_groups.h>
#include <cstdio>
#include <cstdint>
namespace cg = cooperative_groups;

#define LAS __attribute__((address_space(3)))
#define CAS __attribute__((address_space(4)))
typedef const __attribute__((address_space(1))) float* gfptr;
typedef unsigned short bf16_t;
typedef short bf16x8 __attribute__((ext_vector_type(8)));
typedef float f32x4 __attribute__((ext_vector_type(4)));
typedef float f32x2 __attribute__((ext_vector_type(2)));
typedef unsigned u32x4 __attribute__((ext_vector_type(4)));
typedef unsigned u32x2 __attribute__((ext_vector_type(2)));

constexpr int SEQ = 8192, DM = 2048, DFF = 5632, MEML = 256;
constexpr int NHEAD = 32, PW = 10240;
constexpr int PU0 = 0, PZ0 = 2048, PV0 = 4096, PX0 = 6144;
constexpr float EPS = 1e-6f;

constexpr size_t MiB = 1u << 20;
constexpr size_t WS_WGU1 = 1 * MiB, WS_WD1 = 45 * MiB, WS_WIN = 67 * MiB, WS_WOUTA = 108 * MiB, WS_WOUTM = 116 * MiB,
                 WS_WQ = 124 * MiB, WS_WKV = 132 * MiB, WS_WO = 148 * MiB, WS_WGU2 = 156 * MiB, WS_WD2 = 200 * MiB,
                 WS_XN = 222 * MiB, WS_P = 254 * MiB, WS_ST = 414 * MiB, WS_DT = 478 * MiB, WS_VPART = 479 * MiB,
                 WS_YPART = 480 * MiB, WS_CDEC = 481 * MiB, WS_KB = 482 * MiB, WS_VT = 483 * MiB, WS_MEMN = 484 * MiB,
                 WS_HALO = 489 * MiB, WS_NPA = 485 * MiB, WS_NPB = 486 * MiB, WS_NPC = 487 * MiB, WS_NPD = 488 * MiB,
                 WS_END = 495 * MiB;
constexpr size_t WS_ACT = WS_P;
constexpr size_t WS_Q = WS_P, WS_O = WS_P + 32 * MiB, WS_ACT2 = WS_P + 64 * MiB;

constexpr int LDS_BYTES = 147456;
#ifndef PROBE_A
#define PROBE_A -1
#define PROBE_B -1
#endif
#ifndef REP_P0
#define REPU_P5A 1
#define REPU_P7 1
#define REPU_P5B 1
#define REPU_P11 1
#define REPG_P4 1
#define REPG_P2 1
#define REP_SYNC 1
#endif
#ifndef STOP_AFTER
#define STOP_AFTER 99
#endif

typedef __bf16 bf16x2_t __attribute__((ext_vector_type(2)));
__device__ __forceinline__ unsigned cvt_pk_bf16(float lo, float hi) { typedef float f2 __attribute__((ext_vector_type(2))); f2 v = {lo, hi}; bf16x2_t b = __builtin_convertvector(v, bf16x2_t); return __builtin_bit_cast(unsigned, b); }
__device__ __forceinline__ float bflo(unsigned u) { return __uint_as_float(u << 16); }
__device__ __forceinline__ float bfhi(unsigned u) { return __uint_as_float(u & 0xffff0000u); }
__device__ __forceinline__ float bf2f(unsigned short h) { return __uint_as_float(((unsigned)h) << 16); }
__device__ __forceinline__ float silu_f(float x) { return x * __builtin_amdgcn_rcpf(1.0f + __expf(-x)); }
__device__ __forceinline__ float gelu_f(float x) { const float y = 0.7978845608028654f * (x + 0.044715f * x * x * x); return x * __builtin_amdgcn_rcpf(1.0f + __expf(-2.0f * y)); }
__device__ __forceinline__ float wave_sum(float v) {
#pragma unroll
    for (int o = 1; o < 64; o <<= 1) v += __shfl_xor(v, o);
    return v;
}
__device__ __forceinline__ bf16x8 pack8(const float (&v)[8]) {
    u32x4 w; w.x = cvt_pk_bf16(v[0], v[1]); w.y = cvt_pk_bf16(v[2], v[3]); w.z = cvt_pk_bf16(v[4], v[5]); w.w = cvt_pk_bf16(v[6], v[7]);
    return __builtin_bit_cast(bf16x8, w);
}

namespace pg8 {
constexpr int BM = 256, BK = 64, HALF = 128, HTB = HALF * BK * 2, STAGE_BYTES = 8 * HTB, NXCD = 8, WGM = 8;
__host__ __device__ __forceinline__ int lds_byte(int r, int c) { const int st = (r >> 4) * 2 + (c >> 5), rr = r & 15, cc = c & 31, ob = rr * 64 + cc * 2; return st * 1024 + (ob ^ (((ob >> 9) & 1) << 5)); }
__host__ __device__ __forceinline__ void stage_rc(int b, int& R, int& C) { const int st = b / 1024, sb = b % 1024, swz = sb ^ (((sb >> 9) & 1) << 5); R = (st >> 1) * 16 + swz / 64; C = (st & 1) * 32 + (swz % 64) / 2; }
__host__ __device__ __forceinline__ int perm32(int rho) { const int n = rho >> 4, i = rho & 15; return 8 * (i >> 2) + 4 * n + (i & 3); }

struct Unit { int pm, pn; };
struct Gemm { const bf16_t* A; const bf16_t* Bt; int M, N, K, lda; int ks = 1 << 30; long ashift = 0; };

struct StaticOrder {
    int nM, nN, nwg, G, c, rep = 1;
    __host__ __device__ void init(int M, int N, int G_, int c_) { nM = M / BM; nN = N / BM; nwg = nM * nN; G = G_; c = c_; }
    __host__ __device__ bool next(int i, Unit& u) const {
        const long L = (long)i * G + c; if (L >= (long)nwg * rep) return false;
        int wgid = (int)L; if (rep > 1) { while (wgid >= nwg) wgid -= nwg; } { const int q = nwg / NXCD, r = nwg % NXCD, xcd = wgid % NXCD, off = wgid / NXCD; wgid = (xcd < r ? xcd * (q + 1) : r * (q + 1) + (xcd - r) * q) + off; }
        const int nig = WGM * nN, gid = wgid / nig, fm = gid * WGM, gsz = (nM - fm) < WGM ? (nM - fm) : WGM;
        u.pm = fm + ((wgid % nig) % gsz); u.pn = (wgid % nig) / gsz; return true;
    }
};

template <class Epi, class Sched, bool ALIGN_EPI>
__device__ __forceinline__ void gemm_phase(LAS unsigned char* lds, const Gemm g, const Sched& S, const Epi& E) {
    int tid = threadIdx.x; asm volatile("" : "+v"(tid));
    const int wid = __builtin_amdgcn_readfirstlane(tid >> 6), lane = tid & 63, wr = wid >> 2, wc = wid & 3, fr = lane & 15, fq = lane >> 4;
    const int K = g.K, nt = K / BK, lda = g.lda;
    unsigned voffA[2], voffB[2];
#pragma unroll
    for (int i = 0; i < 2; ++i) { int R, C; stage_rc(tid * 16 + i * 8192, R, C); const int Rb = Epi::PERM ? ((R & ~31) + perm32(R & 31)) : R;
        voffA[i] = (unsigned)(R * lda + C) * 2u; voffB[i] = (unsigned)(Rb * K + C) * 2u; }
    const size_t kstep = (size_t)(BK * 2);
    const size_t hstepA = (size_t)HALF * lda * 2, hstepB = (size_t)HALF * K * 2;
    const size_t tstepA = 2 * hstepA, tstepB = 2 * hstepB;
    const unsigned ldsw = (unsigned)wid * 1024u;
    const int aoff = lds_byte(wr * 64 + fr, fq * 8), boff = lds_byte(wc * 32 + fr, fq * 8);
#define PG8_SA(b, h) (((b) * 2 + (h)) * HTB)
#define PG8_SB(b, h) ((4 + (b) * 2 + (h)) * HTB)
#define PG8_STAGE(bufoff, gbase, voff) do { _Pragma("unroll") for (int _i = 0; _i < 2; ++_i) \
        __builtin_amdgcn_global_load_lds((const unsigned*)((const char*)(gbase) + (voff)[_i]), (LAS unsigned*)(lds + (bufoff) + ldsw + _i * 8192), 16, 0, 0); } while (0)
#define PG8_LDA(dst, b, h) do { _Pragma("unroll") for (int m = 0; m < 4; ++m) _Pragma("unroll") for (int k = 0; k < 2; ++k) dst[m][k] = *(const LAS bf16x8*)(lds + PG8_SA(b, h) + aoff + m * 2048 + k * 1024); } while (0)
#define PG8_LDB(dst, b, h) do { _Pragma("unroll") for (int n = 0; n < 2; ++n) _Pragma("unroll") for (int k = 0; k < 2; ++k) dst[n][k] = *(const LAS bf16x8*)(lds + PG8_SB(b, h) + boff + n * 2048 + k * 1024); } while (0)
#define PG8_MMA(ai, bj, At, Bt) do { __builtin_amdgcn_s_setprio(1); _Pragma("unroll") for (int m = 0; m < 4; ++m) _Pragma("unroll") for (int n = 0; n < 2; ++n) _Pragma("unroll") for (int k = 0; k < 2; ++k) \
        acc[ai][bj][m][n] = __builtin_amdgcn_mfma_f32_16x16x32_bf16(Bt[n][k], At[m][k], acc[ai][bj][m][n], 0, 0, 0); __builtin_amdgcn_s_setprio(0); } while (0)
#define PG8_WAIT_V(n) asm volatile("s_waitcnt vmcnt(" #n ")" ::: "memory")
#define PG8_WAIT_L(n) asm volatile("s_waitcnt lgkmcnt(" #n ")" ::: "memory")
#define PG8_BAR __builtin_amdgcn_s_barrier()
#define PG8_SCHED __builtin_amdgcn_sched_barrier(0)
    Unit cur, nxt; int ui = 0;
    if (!S.next(0, cur)) return;
    f32x4 acc[2][2][4][2];
#pragma unroll
    for (int a = 0; a < 2; ++a)
#pragma unroll
        for (int b = 0; b < 2; ++b)
#pragma unroll
            for (int m = 0; m < 4; ++m)
#pragma unroll
                for (int n = 0; n < 2; ++n) acc[a][b][m][n] = (f32x4){0.f, 0.f, 0.f, 0.f};
    bf16x8 At[4][2], B0[2][2], B1[2][2];
    const char* cA = (const char*)g.A + (size_t)cur.pm * tstepA; const char* cB = (const char*)g.Bt + (size_t)cur.pn * tstepB;
    PG8_STAGE(PG8_SB(0, 0), cB, voffB); PG8_STAGE(PG8_SB(0, 1), cB + hstepB, voffB); PG8_STAGE(PG8_SA(0, 0), cA, voffA); PG8_STAGE(PG8_SA(0, 1), cA + hstepA, voffA);
    if (wr == 1) PG8_BAR;
    PG8_WAIT_V(2); PG8_BAR;
    PG8_STAGE(PG8_SB(1, 0), cB + kstep, voffB); PG8_STAGE(PG8_SA(1, 0), cA + kstep, voffA); PG8_STAGE(PG8_SB(1, 1), cB + hstepB + kstep, voffB);
    PG8_WAIT_V(6); PG8_BAR;
    for (;;) {
        const bool has_next = S.next(ui + 1, nxt);
        const char* nA = has_next ? (const char*)g.A + (size_t)nxt.pm * tstepA : cA; const char* nB = has_next ? (const char*)g.Bt + (size_t)nxt.pn * tstepB : cB;
        for (int t = 0; t < nt; t += 2) {
            const bool last = (t == nt - 2);
            if constexpr (Epi::MIDK) { if (t == g.ks) E.mid(acc, cur, ui, wr, wc, fr, fq); }
            const long sh1 = (t >= g.ks) ? g.ashift : 0, sh2 = (t + 2 >= g.ks) ? g.ashift : 0;
            const char* a1 = cA + (size_t)(t + 1) * kstep + sh1;
            const char* a2 = last ? nA : cA + (size_t)(t + 2) * kstep + sh2; const char* b2 = last ? nB : cB + (size_t)(t + 2) * kstep;
            const char* a3 = a2 + kstep; const char* b3 = b2 + kstep;
            PG8_LDB(B0, 0, 0); PG8_LDB(B1, 0, 1); PG8_SCHED; PG8_LDA(At, 0, 0); PG8_STAGE(PG8_SA(1, 1), a1 + hstepA, voffA);
            PG8_WAIT_V(8); PG8_WAIT_L(0); PG8_BAR; PG8_MMA(0, 0, At, B0); PG8_MMA(0, 1, At, B1); PG8_BAR; PG8_SCHED;
            PG8_LDA(At, 0, 1); PG8_STAGE(PG8_SB(0, 0), b2, voffB); PG8_STAGE(PG8_SB(0, 1), b2 + hstepB, voffB); PG8_STAGE(PG8_SA(0, 0), a2, voffA);
            PG8_WAIT_V(8); PG8_WAIT_L(0); PG8_BAR; PG8_MMA(1, 0, At, B0); PG8_MMA(1, 1, At, B1); PG8_BAR; PG8_SCHED;
            PG8_LDB(B0, 1, 0); PG8_LDB(B1, 1, 1); PG8_SCHED; PG8_LDA(At, 1, 0); PG8_STAGE(PG8_SA(0, 1), a2 + hstepA, voffA);
            PG8_WAIT_V(8); PG8_WAIT_L(0); PG8_BAR; PG8_MMA(0, 0, At, B0); PG8_MMA(0, 1, At, B1); PG8_BAR; PG8_SCHED;
            PG8_LDA(At, 1, 1); PG8_STAGE(PG8_SB(1, 0), b3, voffB); PG8_STAGE(PG8_SB(1, 1), b3 + hstepB, voffB); PG8_STAGE(PG8_SA(1, 0), a3, voffA);
            PG8_WAIT_V(8); PG8_WAIT_L(0); PG8_BAR; PG8_MMA(1, 0, At, B0); PG8_MMA(1, 1, At, B1); PG8_BAR; PG8_SCHED;
        }
        if constexpr (ALIGN_EPI) { if (wr == 0) PG8_BAR; }
        E(acc, cur, ui, wr, wc, fr, fq);
        if (!has_next) break;
#pragma unroll
        for (int a = 0; a < 2; ++a)
#pragma unroll
            for (int b = 0; b < 2; ++b)
#pragma unroll
                for (int m = 0; m < 4; ++m)
#pragma unroll
                    for (int n = 0; n < 2; ++n) acc[a][b][m][n] = (f32x4){0.f, 0.f, 0.f, 0.f};
        cur = nxt; cA = nA; cB = nB; ++ui;
        if constexpr (ALIGN_EPI) { if (wr == 1) PG8_BAR; }
    }
    PG8_WAIT_V(0);
    if constexpr (!ALIGN_EPI) { if (wr == 0) PG8_BAR; }
    PG8_BAR;
#undef PG8_SA
#undef PG8_SB
#undef PG8_STAGE
#undef PG8_LDA
#undef PG8_LDB
#undef PG8_MMA
#undef PG8_WAIT_V
#undef PG8_WAIT_L
#undef PG8_BAR
#undef PG8_SCHED
}

__device__ __forceinline__ float row_rstd(const float* part, int row, int fq) {
    const f32x4 p0 = *(const f32x4*)(part + (size_t)row * 32 + fq * 8), p1 = *(const f32x4*)(part + (size_t)row * 32 + fq * 8 + 4);
    float s = (p0[0] + p0[1]) + (p0[2] + p0[3]) + (p1[0] + p1[1]) + (p1[2] + p1[3]); s += __shfl_xor(s, 16); s += __shfl_xor(s, 32);
    return rsqrtf(s * (1.0f / 2048.0f) + EPS);
}
struct EpiSwiGLU {
    static constexpr bool PERM = true, MIDK = false;
    bf16_t* O; int ldc; const LAS float* rsl;
    __device__ __forceinline__ void operator()(const f32x4 (&acc)[2][2][4][2], const Unit& u, int ui, int wr, int wc, int fr, int fq) const {
        const int row0 = u.pm * BM + wr * 64 + fr, col0 = u.pn * HALF + wc * 32 + 8 * fq;
#pragma unroll
        for (int ai = 0; ai < 2; ++ai)
#pragma unroll
            for (int m = 0; m < 4; ++m) {
                const int row = row0 + ai * HALF + m * 16;
                bf16_t* rowp = O + (size_t)row * ldc + col0;
                const float rs = rsl[ui * 256 + (row & 255)];
                float v[8];
#pragma unroll
                for (int n = 0; n < 2; ++n)
#pragma unroll
                    for (int j = 0; j < 4; ++j) v[n * 4 + j] = silu_f(acc[ai][0][m][n][j] * rs) * (acc[ai][1][m][n][j] * rs);
                u32x4 w; w.x = cvt_pk_bf16(v[0], v[1]); w.y = cvt_pk_bf16(v[2], v[3]); w.z = cvt_pk_bf16(v[4], v[5]); w.w = cvt_pk_bf16(v[6], v[7]);
                *(u32x4*)rowp = w;
            }
    }
};
template <bool BASE_F32> struct EpiResid {
    static constexpr bool PERM = true, MIDK = false;
    const void* base; bf16_t* out; int ldc; float alpha; const float* part;
    bf16_t* xn; const float* nw; float* npart;
    __device__ __forceinline__ void operator()(const f32x4 (&acc)[2][2][4][2], const Unit& u, int ui, int wr, int wc, int fr, int fq) const {
        const int col0 = u.pn * BM + wc * 32 + 8 * fq;
#pragma unroll
        for (int ai = 0; ai < 2; ++ai)
#pragma unroll
            for (int m = 0; m < 4; ++m) {
                const int row = u.pm * BM + ai * HALF + wr * 64 + m * 16 + fr;
                float sc = alpha;
                if (part) sc = alpha * row_rstd(part, row, fq);
                const size_t off = (size_t)row * ldc + col0;
                float ss = 0.f;
#pragma unroll
                for (int bj = 0; bj < 2; ++bj) { f32x4 b0, b1;
                    if (BASE_F32) { b0 = *(const f32x4*)((const float*)base + off + bj * HALF); b1 = *(const f32x4*)((const float*)base + off + bj * HALF + 4); }
                    else { const u32x4 r = *(const u32x4*)((const bf16_t*)base + off + bj * HALF); b0 = (f32x4){bflo(r.x), bfhi(r.x), bflo(r.y), bfhi(r.y)}; b1 = (f32x4){bflo(r.z), bfhi(r.z), bflo(r.w), bfhi(r.w)}; }
                    const f32x4 o0 = b0 + acc[ai][bj][m][0] * sc, o1 = b1 + acc[ai][bj][m][1] * sc;
                    u32x4 ho; ho.x = cvt_pk_bf16(o0[0], o0[1]); ho.y = cvt_pk_bf16(o0[2], o0[3]); ho.z = cvt_pk_bf16(o1[0], o1[1]); ho.w = cvt_pk_bf16(o1[2], o1[3]);
                    *(u32x4*)(out + off + bj * HALF) = ho;
                    if (xn) { const f32x4 w0 = *(const f32x4*)(nw + col0 + bj * HALF), w1 = *(const f32x4*)(nw + col0 + bj * HALF + 4);
                        ss += ((o0[0] * o0[0] + o0[1] * o0[1]) + (o0[2] * o0[2] + o0[3] * o0[3])) + ((o1[0] * o1[0] + o1[1] * o1[1]) + (o1[2] * o1[2] + o1[3] * o1[3]));
                        u32x4 q; q.x = cvt_pk_bf16(o0[0] * w0[0], o0[1] * w0[1]); q.y = cvt_pk_bf16(o0[2] * w0[2], o0[3] * w0[3]); q.z = cvt_pk_bf16(o1[0] * w1[0], o1[1] * w1[1]); q.w = cvt_pk_bf16(o1[2] * w1[2], o1[3] * w1[3]);
                        *(u32x4*)(xn + off + bj * HALF) = q; } }
                if (xn) { ss += __shfl_xor(ss, 16); ss += __shfl_xor(ss, 32); if (fq == 0) npart[(size_t)row * 32 + u.pn * 4 + wc] = ss; }
            }
    }
};
struct EpiResidMid : EpiResid<false> {
    static constexpr bool MIDK = true;
    const LAS float* rsl;
    __device__ __forceinline__ void mid(f32x4 (&acc)[2][2][4][2], const Unit& u, int ui, int wr, int wc, int fr, int fq) const {
#pragma unroll
        for (int ai = 0; ai < 2; ++ai)
#pragma unroll
            for (int m = 0; m < 4; ++m) { const float rs = rsl[ui * 256 + ai * HALF + wr * 64 + m * 16 + fr];
#pragma unroll
                for (int bj = 0; bj < 2; ++bj)
#pragma unroll
                    for (int n = 0; n < 2; ++n) acc[ai][bj][m][n] = acc[ai][bj][m][n] * rs; }
    }
};
struct EpiBf16 {
    static constexpr bool PERM = true, MIDK = false;
    bf16_t* O; int ldc; float scale0; const LAS float* rsl;
    __device__ __forceinline__ void operator()(const f32x4 (&acc)[2][2][4][2], const Unit& u, int ui, int wr, int wc, int fr, int fq) const {
        const int row0 = u.pm * BM + wr * 64 + fr, col0 = u.pn * BM + wc * 32 + 8 * fq;
#pragma unroll
        for (int ai = 0; ai < 2; ++ai)
#pragma unroll
            for (int m = 0; m < 4; ++m) { const int row = row0 + ai * HALF + m * 16; bf16_t* rowp = O + (size_t)row * ldc + col0;
                const float scale = scale0 * rsl[ui * 256 + (row & 255)];
#pragma unroll
                for (int bj = 0; bj < 2; ++bj) { const f32x4 v0 = acc[ai][bj][m][0] * scale, v1 = acc[ai][bj][m][1] * scale;
                    u32x4 w; w.x = cvt_pk_bf16(v0[0], v0[1]); w.y = cvt_pk_bf16(v0[2], v0[3]); w.z = cvt_pk_bf16(v1[0], v1[1]); w.w = cvt_pk_bf16(v1[2], v1[3]);
                    *(u32x4*)(rowp + bj * HALF) = w; } }
    }
};
struct EpiKV {
    static constexpr bool PERM = true, MIDK = false;
    bf16_t* KB; bf16_t* VT;
    __device__ __forceinline__ void operator()(const f32x4 (&acc)[2][2][4][2], const Unit& u, int ui, int wr, int wc, int fr, int fq) const {
        const int row0 = u.pm * BM + wr * 64 + fr, col0 = u.pn * BM + wc * 32 + 8 * fq;
#pragma unroll
        for (int ai = 0; ai < 2; ++ai)
#pragma unroll
            for (int m = 0; m < 4; ++m) { const int row = row0 + ai * HALF + m * 16;
#pragma unroll
                for (int bj = 0; bj < 2; ++bj) { const int col = col0 + bj * HALF;
                    if (col < 2048) { const f32x4 v0 = acc[ai][bj][m][0], v1 = acc[ai][bj][m][1];
                        u32x4 w; w.x = cvt_pk_bf16(v0[0], v0[1]); w.y = cvt_pk_bf16(v0[2], v0[3]); w.z = cvt_pk_bf16(v1[0], v1[1]); w.w = cvt_pk_bf16(v1[2], v1[3]);
                        *(u32x4*)(KB + (size_t)row * 2048 + col) = w;
                    } else {
#pragma unroll
                        for (int n = 0; n < 2; ++n)
#pragma unroll
                            for (int j = 0; j < 4; ++j) VT[(size_t)(col - 2048 + n * 4 + j) * 256 + row] = (bf16_t)(cvt_pk_bf16(acc[ai][bj][m][n][j], 0.f) & 0xffffu);
                    } } }
    }
};
struct EpiWin {
    static constexpr bool PERM = true, MIDK = false;
    bf16_t* P; float* dt; float* vpart; const LAS float* rsl; bf16_t* halo;
    __device__ __forceinline__ void operator()(const f32x4 (&acc)[2][2][4][2], const Unit& u, int ui, int wr, int wc, int fr, int fq) const {
        const int pn = u.pn;
        const int row0 = u.pm * BM + wr * 64 + fr;
        if (pn == 40) {
            if (wc == 0) {
#pragma unroll
                for (int ai = 0; ai < 2; ++ai)
#pragma unroll
                    for (int m = 0; m < 4; ++m) { const int row = row0 + ai * HALF + m * 16; float* rp = dt + (size_t)row * 32 + 8 * fq; const float rs = rsl[ui * 256 + (row & 255)];
                        *(f32x4*)rp = acc[ai][0][m][0] * rs; *(f32x4*)(rp + 4) = acc[ai][0][m][1] * rs; }
            }
            return;
        }
        const int mode = pn < 8 ? 0 : (pn < 16 ? 1 : (pn < 24 ? 2 : 3));
        const int col0 = pn * BM + wc * 32 + 8 * fq;
#pragma unroll
        for (int ai = 0; ai < 2; ++ai)
#pragma unroll
            for (int m = 0; m < 4; ++m) { const int row = row0 + ai * HALF + m * 16; bf16_t* rowp = P + (size_t)row * PW + col0; float ss = 0.f; const float rs = rsl[ui * 256 + (row & 255)];
#pragma unroll
                for (int bj = 0; bj < 2; ++bj) { float v[8];
#pragma unroll
                    for (int n = 0; n < 2; ++n)
#pragma unroll
                        for (int j = 0; j < 4; ++j) { float x = acc[ai][bj][m][n][j] * rs;
                            if (mode == 0 || mode == 2) x = gelu_f(x); else if (mode == 1) x = silu_f(x);
                            v[n * 4 + j] = x; ss += x * x; }
                    u32x4 w; w.x = cvt_pk_bf16(v[0], v[1]); w.y = cvt_pk_bf16(v[2], v[3]); w.z = cvt_pk_bf16(v[4], v[5]); w.w = cvt_pk_bf16(v[6], v[7]);
                    *(u32x4*)(rowp + bj * HALF) = w;
                    if (mode == 3 && (row & 31) >= 29) *(u32x4*)(halo + ((size_t)(row >> 5) * 3 + (row & 31) - 29) * 4096 + (col0 + bj * HALF - PX0)) = w; }
                if (mode == 2) { ss += __shfl_xor(ss, 16); ss += __shfl_xor(ss, 32); if (fq == 0) vpart[(size_t)row * 32 + (pn - 16) * 4 + wc] = ss; }
            }
    }
};
struct EpiFinal {
    static constexpr bool PERM = false, MIDK = false;
    const bf16_t* base; float* out; int ldc; float alpha; const float* nw;
    float* slots;
    unsigned* cnt;
    LAS float* ex;
    __device__ __forceinline__ void operator()(f32x4 (&acc)[2][2][4][2], const Unit& u, int ui, int wr, int wc, int fr, int fq) const {
        const int col0 = u.pn * BM + wc * 32 + 4 * fq;
        int tid = threadIdx.x; asm volatile("" : "+v"(tid));
        LAS float* Pl = ex; LAS float* Sl = ex + 1024;
#pragma unroll
        for (int ai = 0; ai < 2; ++ai)
#pragma unroll
            for (int m = 0; m < 4; ++m) {
                const int rl = ai * HALF + wr * 64 + m * 16 + fr; const size_t off = (size_t)(u.pm * BM + rl) * ldc + col0; float ss = 0.f;
#pragma unroll
                for (int bj = 0; bj < 2; ++bj)
#pragma unroll
                    for (int n = 0; n < 2; ++n) { const u32x2 r = *(const u32x2*)(base + off + bj * HALF + n * 16); const f32x4 b = {bflo(r.x), bfhi(r.x), bflo(r.y), bfhi(r.y)}; const f32x4 o = b + acc[ai][bj][m][n] * alpha; acc[ai][bj][m][n] = o;
                        ss += (o[0] * o[0] + o[1] * o[1]) + (o[2] * o[2] + o[3] * o[3]); }
                ss += __shfl_xor(ss, 16); ss += __shfl_xor(ss, 32);
                if (fq == 0) Pl[rl * 4 + wc] = ss;
            }
        __syncthreads();
        if (tid < 256) { const float t = (Pl[tid * 4 + 0] + Pl[tid * 4 + 1]) + (Pl[tid * 4 + 2] + Pl[tid * 4 + 3]);
            __hip_atomic_store(slots + (size_t)(u.pm * BM + tid) * 8 + u.pn, t, __ATOMIC_RELAXED, __HIP_MEMORY_SCOPE_AGENT);
            asm volatile("s_waitcnt vmcnt(0)" ::: "memory");
            if ((tid & 63) == 0) __hip_atomic_fetch_add(cnt + 64 * u.pm, 1u, __ATOMIC_RELAXED, __HIP_MEMORY_SCOPE_AGENT); }
        if (tid < 64) { unsigned sp = 0;
            while (__hip_atomic_load(cnt + 64 * u.pm, __ATOMIC_RELAXED, __HIP_MEMORY_SCOPE_AGENT) < 32u) { __builtin_amdgcn_s_sleep(1); if (++sp > (1u << 22)) break; }
            __builtin_amdgcn_fence(__ATOMIC_ACQUIRE, "agent"); asm volatile("s_waitcnt vmcnt(0)" ::: "memory"); }
        __syncthreads();
        if (tid < 256) { const float* sp = slots + (size_t)(u.pm * BM + tid) * 8; float t = 0.f;
#pragma unroll
            for (int q = 0; q < 8; ++q) t += __hip_atomic_load(sp + q, __ATOMIC_RELAXED, __HIP_MEMORY_SCOPE_AGENT);
            Sl[tid] = rsqrtf(t * (1.0f / 2048.0f) + EPS); }
        __syncthreads();
#pragma unroll
        for (int ai = 0; ai < 2; ++ai)
#pragma unroll
            for (int m = 0; m < 4; ++m) { const int rl = ai * HALF + wr * 64 + m * 16 + fr; const size_t off = (size_t)(u.pm * BM + rl) * ldc + col0; const float rs = Sl[rl];
#pragma unroll
                for (int bj = 0; bj < 2; ++bj)
#pragma unroll
                    for (int n = 0; n < 2; ++n) { const f32x4 w = *(const f32x4*)(nw + col0 + bj * HALF + n * 16); __builtin_nontemporal_store(acc[ai][bj][m][n] * rs * w, (f32x4*)(out + off + bj * HALF + n * 16)); }
            }
    }
};
}

template <class Sched> __device__ __forceinline__ void prep_rstd(const Sched& S, const float* part, LAS float* rsl) {
    const int tid = threadIdx.x; pg8::Unit u;
    for (int i0 = 0; S.next(i0, u); i0 += 2) {
        const int i = i0 + (tid >> 8);
        if (S.next(i, u)) { const f32x4* pp = (const f32x4*)(part + (size_t)(u.pm * 256 + (tid & 255)) * 32); float sm = 0.f;
#pragma unroll
            for (int q = 0; q < 8; ++q) { const f32x4 t = pp[q]; sm += (t[0] + t[1]) + (t[2] + t[3]); }
            rsl[i * 256 + (tid & 255)] = rsqrtf(sm * (1.f / 2048.f) + EPS); }
    }
    __syncthreads();
}

struct Args { const float* in[26]; float* out; unsigned char* ws; };

__device__ __forceinline__ int maprow(int mode, int n0) {
    if (mode == 1) { return n0 < DFF ? (n0 / 128) * 256 + (n0 % 128) : ((n0 - DFF) / 128) * 256 + 128 + ((n0 - DFF) % 128); }
    if (mode == 2) { return (n0 >= 2048 && n0 < 4096) ? n0 + 2048 : ((n0 >= 4096 && n0 < 6144) ? n0 - 2048 : n0); }
    return n0;
}
__device__ __forceinline__ void tr_item(const float* W, int K, int N, bf16_t* WT, int mode, LAS float* scr, int item, int lane) {
    const int nblk = N / 32, kb = item / nblk, nb = item % nblk, k0 = 64 * kb, n0 = 32 * nb;
    const int r0 = maprow(mode, n0);
    const int kd = (mode == 3) ? ((k0 + 2048) & 4095) : k0;
    f32x4 ld[8];
#pragma unroll
    for (int i = 0; i < 8; ++i) ld[i] = __builtin_nontemporal_load((const f32x4*)(W + (size_t)(k0 + 8 * i + (lane >> 3)) * N + n0 + (lane & 7) * 4));
#pragma unroll
    for (int i = 0; i < 8; ++i) { LAS float* d = scr + (8 * i + (lane >> 3)) * 33 + (lane & 7) * 4; d[0] = ld[i][0]; d[1] = ld[i][1]; d[2] = ld[i][2]; d[3] = ld[i][3]; }
    asm volatile("s_waitcnt lgkmcnt(0)" ::: "memory");
    const int c = lane & 7;
#pragma unroll
    for (int j = 0; j < 4; ++j) { const int n = (lane >> 3) + 8 * j; const LAS float* s = scr + (8 * c) * 33 + n;
        u32x4 o; o.x = cvt_pk_bf16(s[0 * 33], s[1 * 33]); o.y = cvt_pk_bf16(s[2 * 33], s[3 * 33]); o.z = cvt_pk_bf16(s[4 * 33], s[5 * 33]); o.w = cvt_pk_bf16(s[6 * 33], s[7 * 33]);
        *(u32x4*)(WT + (size_t)(r0 + n) * K + kd + 8 * c) = o; }
    asm volatile("s_waitcnt lgkmcnt(0)" ::: "memory");
}
__device__ __forceinline__ void norm_row_bf16(const float* xrow, const float* w, bf16_t* orow, int lane) {
    const f32x4* xr = (const f32x4*)xrow + lane; const f32x4* wr = (const f32x4*)w + lane;
    f32x4 v[8]; float s = 0.f;
#pragma unroll
    for (int j = 0; j < 8; ++j) { v[j] = xr[64 * j]; s += (v[j].x * v[j].x + v[j].y * v[j].y) + (v[j].z * v[j].z + v[j].w * v[j].w); }
    const float rstd = rsqrtf(wave_sum(s) * (1.f / 2048.f) + EPS);
    u32x2* o8 = (u32x2*)orow + lane;
#pragma unroll
    for (int j = 0; j < 8; ++j) { const f32x4 ww = wr[64 * j]; u32x2 o; o.x = cvt_pk_bf16(v[j].x * rstd * ww.x, v[j].y * rstd * ww.y); o.y = cvt_pk_bf16(v[j].z * rstd * ww.z, v[j].w * rstd * ww.w); o8[64 * j] = o; }
}
__device__ __forceinline__ void wrow_bf16(const float* xrow, const float* w, bf16_t* orow, float* part, int lane) {
    const f32x4* xr = (const f32x4*)xrow + lane; const f32x4* wr = (const f32x4*)w + lane;
    f32x4 v[8]; float s = 0.f;
#pragma unroll
    for (int j = 0; j < 8; ++j) { v[j] = xr[64 * j]; s += (v[j].x * v[j].x + v[j].y * v[j].y) + (v[j].z * v[j].z + v[j].w * v[j].w); }
    s = wave_sum(s);
    if (lane < 32) part[lane] = lane == 0 ? s : 0.f;
    u32x2* o8 = (u32x2*)orow + lane;
#pragma unroll
    for (int j = 0; j < 8; ++j) { const f32x4 ww = wr[64 * j]; u32x2 o; o.x = cvt_pk_bf16(v[j].x * ww.x, v[j].y * ww.y); o.y = cvt_pk_bf16(v[j].z * ww.z, v[j].w * ww.w); o8[64 * j] = o; }
}
__device__ __forceinline__ void norm_row_from_bf16(const bf16_t* xrow, const float* w, float* orow, int lane) {
    const u32x2* xr = (const u32x2*)xrow + lane; const f32x4* wr = (const f32x4*)w + lane;
    f32x4 v[8]; float s = 0.f;
#pragma unroll
    for (int j = 0; j < 8; ++j) { const u32x2 r = xr[64 * j]; v[j] = (f32x4){bflo(r.x), bfhi(r.x), bflo(r.y), bfhi(r.y)}; s += (v[j].x * v[j].x + v[j].y * v[j].y) + (v[j].z * v[j].z + v[j].w * v[j].w); }
    const float rstd = rsqrtf(wave_sum(s) * (1.f / 2048.f) + EPS);
    f32x4* o = (f32x4*)orow + lane;
#pragma unroll
    for (int j = 0; j < 8; ++j) { const f32x4 ww = wr[64 * j]; o[64 * j] = v[j] * rstd * ww; }
}
__device__ __forceinline__ void norm_row_f32(const float* xrow, const float* w, float* orow, int lane, float addc) {
    const f32x4* xr = (const f32x4*)xrow + lane; const f32x4* wr = (const f32x4*)w + lane;
    f32x4 v[8]; float s = 0.f;
#pragma unroll
    for (int j = 0; j < 8; ++j) { v[j] = xr[64 * j]; s += (v[j].x * v[j].x + v[j].y * v[j].y) + (v[j].z * v[j].z + v[j].w * v[j].w); }
    const float rstd = rsqrtf(wave_sum(s) * (1.f / 2048.f) + EPS);
    f32x4* o = (f32x4*)orow + lane;
#pragma unroll
    for (int j = 0; j < 8; ++j) { const f32x4 ww = wr[64 * j]; o[64 * j] = v[j] * rstd * ww + addc; }
}

constexpr int LP = 272;
__device__ __forceinline__ void conv8(const bf16_t* P, int tok, int col, int ch, const float* cw, const float* cb, float (&o)[8]) {
    const f32x4 b0 = *(const f32x4*)(cb + ch), b1 = *(const f32x4*)(cb + ch + 4);
    float a[8] = {b0[0], b0[1], b0[2], b0[3], b1[0], b1[1], b1[2], b1[3]};
#pragma unroll
    for (int k = 0; k < 4; ++k) { const int r = tok - 3 + k;
        if (r >= 0) { const u32x4 raw = *(const u32x4*)(P + (size_t)r * PW + col);
            const f32x4 w0 = *(const f32x4*)(cw + k * 4096 + ch), w1 = *(const f32x4*)(cw + k * 4096 + ch + 4);
            a[0] += bflo(raw.x) * w0[0]; a[1] += bfhi(raw.x) * w0[1]; a[2] += bflo(raw.y) * w0[2]; a[3] += bfhi(raw.y) * w0[3];
            a[4] += bflo(raw.z) * w1[0]; a[5] += bfhi(raw.z) * w1[1]; a[6] += bflo(raw.w) * w1[2]; a[7] += bfhi(raw.w) * w1[3]; } }
#pragma unroll
    for (int i = 0; i < 8; ++i) o[i] = silu_f(a[i]);
}
__device__ __forceinline__ float softplus_f(float x) { return x > 20.f ? x : log1pf(expf(x)); }
__device__ __forceinline__ void dt_cum(const float* dtraw, int tok0, int h, const float* dt_bias, const float* a_log, LAS float* dtv, LAS float* cum, int lane) {
    const float bias = dt_bias[h], a = -expf(a_log[h]);
    const int l0 = 2 * lane;
    const float d0 = softplus_f(dtraw[(size_t)(tok0 + l0) * 32 + h] + bias), d1 = softplus_f(dtraw[(size_t)(tok0 + l0 + 1) * 32 + h] + bias);
    const float s0 = d0 * a, s1 = s0 + d1 * a;
    float incl = s1;
#pragma unroll
    for (int o = 1; o < 64; o <<= 1) { const float t = __shfl_up(incl, o); if (lane >= o) incl += t; }
    const float excl = incl - s1;
    cum[l0] = excl + s0; cum[l0 + 1] = incl; dtv[l0] = d0; dtv[l0 + 1] = d1;
}

#define XB_TMO      128
#define XB_XCNT(j)  (256  + 64 * (j))
#define XB_XSUB(j)  (1280 + 64 * (j))
#define XB_XGEN(j)  (2304 + 64 * (j))
#define XB_TOP      3328
#define XB_TOPGEN   3392
#define XCD_BAR_WORDS 3456
#define XB_SPIN_CAP (1u << 22)
__device__ __forceinline__ unsigned xb_ld(unsigned* p)              { return __hip_atomic_load(p, __ATOMIC_RELAXED, __HIP_MEMORY_SCOPE_AGENT); }
__device__ __forceinline__ unsigned xb_add(unsigned* p, unsigned v) { return __hip_atomic_fetch_add(p, v, __ATOMIC_RELAXED, __HIP_MEMORY_SCOPE_AGENT); }
__device__ __forceinline__ unsigned xb_xcc_id() { return (unsigned)__builtin_amdgcn_s_getreg((3 << 11) | 20) & 0xFu; }
#define XB_SPIN(cond, bar) do { unsigned _sp = 0; while (cond) { __builtin_amdgcn_s_sleep(1); \
    if ((++_sp & 255u) == 0u) { if (xb_ld(&(bar)[XB_TMO])) break; if (_sp > XB_SPIN_CAP) { atomicAdd(&(bar)[XB_TMO], 1u); break; } } } } while (0)
struct XcdBarrier { unsigned* bar; unsigned x; volatile LAS unsigned* st; };
__device__ __forceinline__ XcdBarrier xcd_barrier_post(unsigned* bar, volatile LAS unsigned* st) {
    XcdBarrier b; b.bar = bar; b.x = xb_xcc_id(); b.st = st;
    if (threadIdx.x == 0) (void)xb_add(&bar[XB_XCNT(b.x)], 1u);
    return b;
}
__device__ __forceinline__ void xcd_barrier_complete(unsigned* bar, unsigned x, unsigned& nloc, unsigned& nx) {
    const unsigned G = gridDim.x * gridDim.y * gridDim.z;
    unsigned sum, cnt, mine, sp = 0u;
    for (;;) {
        sum = 0u; cnt = 0u; mine = 0u;
#pragma unroll
        for (unsigned j = 0; j < 16; ++j) { const unsigned c = xb_ld(&bar[XB_XCNT(j)]); sum += c; cnt += (c > 0u) ? 1u : 0u; mine = (j == x) ? c : mine; }
        if (sum == G) break;
        __builtin_amdgcn_s_sleep(1);
        if ((++sp & 255u) == 0u) { if (xb_ld(&bar[XB_TMO])) break; if (sp > XB_SPIN_CAP) { atomicAdd(&bar[XB_TMO], 1u); break; } }
    }
    nloc = mine > 0u ? mine : 1u; nx = cnt > 0u ? cnt : 1u;
}
__device__ __forceinline__ void xcd_barrier(const XcdBarrier& b) {
    asm volatile("s_waitcnt vmcnt(0)" ::: "memory");
    __syncthreads();
    if (threadIdx.x == 0) {
        unsigned* bar = b.bar;
        __builtin_amdgcn_s_waitcnt(0);
        unsigned nloc = b.st[0], nx = b.st[1];
        if (nloc == 0u) { xcd_barrier_complete(bar, b.x, nloc, nx); b.st[0] = nloc; b.st[1] = nx; }
        const unsigned old = xb_add(&bar[XB_XSUB(b.x)], 1u);
        const unsigned gen = old / nloc;
        if (old + 1u == (gen + 1u) * nloc) {
            __builtin_amdgcn_fence(__ATOMIC_RELEASE, "agent");
            asm volatile("s_waitcnt vmcnt(0)" ::: "memory");
            const unsigned og = xb_add(&bar[XB_TOP], 1u);
            const unsigned tg = og / nx;
            if (og + 1u == (tg + 1u) * nx) xb_add(&bar[XB_TOPGEN], 1u);
            else XB_SPIN(xb_ld(&bar[XB_TOPGEN]) == tg, bar);
            __builtin_amdgcn_fence(__ATOMIC_ACQUIRE, "agent");
            xb_add(&bar[XB_XGEN(b.x)], 1u);
            asm volatile("s_waitcnt vmcnt(0)" ::: "memory");
        } else {
            XB_SPIN(xb_ld(&bar[XB_XGEN(b.x)]) == gen, bar);
            __builtin_amdgcn_fence(__ATOMIC_ACQUIRE, "agent");
            asm volatile("s_waitcnt vmcnt(0)" ::: "memory");
        }
    }
    __syncthreads();
}

#define CG_SYNC() do { asm volatile("s_waitcnt vmcnt(0) lgkmcnt(0)" ::: "memory"); __syncthreads(); grid.sync(); __builtin_amdgcn_fence(__ATOMIC_ACQUIRE, "agent"); asm volatile("s_waitcnt vmcnt(0)" ::: "memory"); __syncthreads(); } while (0)
#define GRID_SYNC() for (int rs_ = 0; rs_ < REP_SYNC; ++rs_) xcd_barrier(xbar)
__device__ __forceinline__ void dt_cum_r(float r0, float r1, int h, const float* dt_bias, const float* a_log, LAS float* dtv, LAS float* cum, int lane) {
    const float bias = dt_bias[h], a = -expf(a_log[h]);
    const int l0 = 2 * lane;
    const float d0 = softplus_f(r0 + bias), d1 = softplus_f(r1 + bias);
    const float s0 = d0 * a, s1 = s0 + d1 * a;
    float incl = s1;
#pragma unroll
    for (int o = 1; o < 64; o <<= 1) { const float t = __shfl_up(incl, o); if (lane >= o) incl += t; }
    const float excl = incl - s1;
    cum[l0] = excl + s0; cum[l0 + 1] = incl; dtv[l0] = d0; dtv[l0 + 1] = d1;
}
#define SCATTER8(dst, raw) do { \
    *(LAS unsigned short*)((dst) + 0 * LP) = (unsigned short)((raw).x & 0xffffu); *(LAS unsigned short*)((dst) + 1 * LP) = (unsigned short)((raw).x >> 16); \
    *(LAS unsigned short*)((dst) + 2 * LP) = (unsigned short)((raw).y & 0xffffu); *(LAS unsigned short*)((dst) + 3 * LP) = (unsigned short)((raw).y >> 16); \
    *(LAS unsigned short*)((dst) + 4 * LP) = (unsigned short)((raw).z & 0xffffu); *(LAS unsigned short*)((dst) + 5 * LP) = (unsigned short)((raw).z >> 16); \
    *(LAS unsigned short*)((dst) + 6 * LP) = (unsigned short)((raw).w & 0xffffu); *(LAS unsigned short*)((dst) + 7 * LP) = (unsigned short)((raw).w >> 16); } while (0)
#define MFMA16(a, b, c) __builtin_amdgcn_mfma_f32_16x16x32_bf16((a), (b), (c), 0, 0, 0)

__global__ void __launch_bounds__(512, 2) mega_fwd(Args args) {
    extern __shared__ __attribute__((aligned(16))) unsigned char lds_raw[];
    LAS unsigned char* lds = (LAS unsigned char*)lds_raw;
    cg::grid_group grid = cg::this_grid();
    const int G = gridDim.x, bid = blockIdx.x;
#define PHASE_IDS const CAS gfptr* inp = (const CAS gfptr*)__builtin_amdgcn_kernarg_segment_ptr(); asm volatile("" : "+s"(inp)); (void)inp; int tid = threadIdx.x; asm volatile("" : "+v"(tid)); const int lane = tid & 63, wave = __builtin_amdgcn_readfirstlane(tid >> 6); \
    const int gw = bid * 8 + wave, NGW = G * 8; const int fr = lane & 15, fq = lane >> 4; (void)gw; (void)NGW; (void)fr; (void)fq; (void)lane;
    unsigned char* ws = args.ws;
    volatile LAS unsigned* MISC = (volatile LAS unsigned*)(lds + LDS_BYTES - 128);
    if (threadIdx.x < 32) MISC[threadIdx.x] = 0u;
    __syncthreads();
    const XcdBarrier xbar = xcd_barrier_post((unsigned*)ws, MISC + 8);
    unsigned long long pa0 = 0, pa1 = 0, pb0 = 0, pb1 = 0;
#define STAMP(k) do { if (PROBE_A >= 0) { const unsigned long long t_ = __builtin_amdgcn_s_memrealtime(); if ((k) == PROBE_A) pa0 = t_; if ((k) == PROBE_A + 1) pa1 = t_; if ((k) == PROBE_B) pb0 = t_; if ((k) == PROBE_B + 1) pb1 = t_; } } while (0)
    STAMP(0);
    bf16_t* HB = (bf16_t*)(ws + WS_WGU1);
    bf16_t* WGU1 = (bf16_t*)(ws + WS_WGU1); bf16_t* WD1 = (bf16_t*)(ws + WS_WD1); bf16_t* WIN = (bf16_t*)(ws + WS_WIN);
    bf16_t* WOUTA = (bf16_t*)(ws + WS_WOUTA); bf16_t* WOUTM = (bf16_t*)(ws + WS_WOUTM); bf16_t* WQ = (bf16_t*)(ws + WS_WQ);
    bf16_t* WKV = (bf16_t*)(ws + WS_WKV); bf16_t* WO = (bf16_t*)(ws + WS_WO); bf16_t* WGU2 = (bf16_t*)(ws + WS_WGU2); bf16_t* WD2 = (bf16_t*)(ws + WS_WD2);
    bf16_t* XN = (bf16_t*)(ws + WS_XN); bf16_t* P = (bf16_t*)(ws + WS_P); bf16_t* ACT = (bf16_t*)(ws + WS_ACT); bf16_t* ACT2 = (bf16_t*)(ws + WS_ACT2);
    bf16_t* QB = (bf16_t*)(ws + WS_Q); bf16_t* OB = (bf16_t*)(ws + WS_O);
    float* ST = (float*)(ws + WS_ST); float* DT = (float*)(ws + WS_DT); float* VPART = (float*)(ws + WS_VPART); float* YPART = (float*)(ws + WS_YPART);
    float* NPA = (float*)(ws + WS_NPA); float* NPB = (float*)(ws + WS_NPB); float* NPC = (float*)(ws + WS_NPC); float* NPD = (float*)(ws + WS_NPD);
    bf16_t* HALO = (bf16_t*)(ws + WS_HALO);
    float* CDEC = (float*)(ws + WS_CDEC); bf16_t* KB = (bf16_t*)(ws + WS_KB); bf16_t* VT = (bf16_t*)(ws + WS_VT); bf16_t* MEMN = (bf16_t*)(ws + WS_MEMN);

    constexpr int I_GU = 32 * 352, I_DN = 88 * 64, I_WIN = 32 * 321, I_SQ = 32 * 64, I_KV = 32 * 128;
    constexpr int CV_P0_END = I_GU + I_KV, CV_P1_END = I_GU + I_KV + I_WIN + I_DN, CV_END = 2 * I_GU + 2 * I_DN + I_WIN + 4 * I_SQ + I_KV, CV_P4_END = CV_END - I_DN;
#define CONVERT_RANGE(lo, hi, rank, nwork) do { LAS float* scr_ = (LAS float*)(lds + wave * 16384); \
        for (int it_ = (lo) + (rank) * 8 + wave; it_ < (hi); it_ += (nwork) * 8) { int r_ = it_; \
            if (r_ < I_GU) { tr_item(((const float*)inp[3]), DM, 2 * DFF, WGU1, 1, scr_, r_, lane); continue; } r_ -= I_GU; \
            if (r_ < I_KV) { tr_item(((const float*)inp[20]), DM, 2 * DM, WKV, 0, scr_, r_, lane); continue; } r_ -= I_KV; \
            if (r_ < I_WIN) { tr_item(((const float*)inp[6]), DM, 10272, WIN, 2, scr_, r_, lane); continue; } r_ -= I_WIN; \
            if (r_ < I_DN) { tr_item(((const float*)inp[4]), DFF, DM, WD1, 0, scr_, r_, lane); continue; } r_ -= I_DN; \
            if (r_ < 2 * I_SQ) { tr_item(((const float*)inp[16]), 2 * DM, DM, WOUTA, 3, scr_, r_, lane); continue; } r_ -= 2 * I_SQ; \
            if (r_ < I_SQ) { tr_item(((const float*)inp[19]), DM, DM, WQ, 0, scr_, r_, lane); continue; } r_ -= I_SQ; \
            if (r_ < I_SQ) { tr_item(((const float*)inp[21]), DM, DM, WO, 0, scr_, r_, lane); continue; } r_ -= I_SQ; \
            if (r_ < I_GU) { tr_item(((const float*)inp[23]), DM, 2 * DFF, WGU2, 1, scr_, r_, lane); continue; } r_ -= I_GU; \
            tr_item(((const float*)inp[24]), DFF, DM, WD2, 0, scr_, r_, lane); } } while (0)

    { PHASE_IDS
        CONVERT_RANGE(0, CV_P0_END, bid, G);
        for (int m = gw; m < SEQ + MEML; m += NGW) {
            if (m < SEQ) wrow_bf16(((const float*)inp[0]) + (size_t)m * DM, ((const float*)inp[2]), XN + (size_t)m * DM, NPD + (size_t)m * 32, lane);
            else norm_row_bf16(((const float*)inp[1]) + (size_t)(m - SEQ) * DM, ((const float*)inp[18]), MEMN + (size_t)(m - SEQ) * DM, lane);
        }
    }
    if (args.out == nullptr) CG_SYNC();
    GRID_SYNC(); STAMP(1);

    {
        pg8::Gemm g{XN, WGU1, SEQ, 2 * DFF, DM, DM}; pg8::StaticOrder S; S.init(SEQ, 2 * DFF, G, bid);
        LAS float* rsl = (LAS float*)(lds + 131072); prep_rstd(S, NPD, rsl);
        pg8::EpiSwiGLU E{ACT, DFF, rsl};
        pg8::gemm_phase<pg8::EpiSwiGLU, pg8::StaticOrder, true>(lds, g, S, E);
        pg8::Gemm g2{MEMN, WKV, MEML, 2 * DM, DM, DM}; pg8::StaticOrder S2; S2.init(MEML, 2 * DM, G, (bid + G - (G / 2)) % G);
        pg8::EpiKV E2{KB, VT};
        pg8::gemm_phase<pg8::EpiKV, pg8::StaticOrder, true>(lds, g2, S2, E2);
        { PHASE_IDS
            const int ntile = 32 * 44, full = (ntile + G - 1) / G, istart = ntile - (full - 1) * G + 16; const bool all = istart >= G;
            __syncthreads();
            if (all || bid >= istart) CONVERT_RANGE(CV_P0_END, CV_P1_END, (all ? bid : bid - istart), (all ? G : G - istart)); }
    }
    GRID_SYNC(); STAMP(2);

    {
        pg8::Gemm g{ACT, WD1, SEQ, DM, DFF, DFF}; pg8::StaticOrder S; S.init(SEQ, DM, G, bid); S.rep = REPG_P2;
        const CAS gfptr* inp = (const CAS gfptr*)__builtin_amdgcn_kernarg_segment_ptr();
        pg8::EpiResid<true> E{((const float*)inp[0]), HB, DM, 0.5f, nullptr, XN, ((const float*)inp[5]), NPA};
        pg8::gemm_phase<pg8::EpiResid<true>, pg8::StaticOrder, true>(lds, g, S, E);
    }
    GRID_SYNC(); STAMP(3);


    {
        pg8::Gemm g{XN, WIN, SEQ, 41 * 256, DM, DM}; pg8::StaticOrder S; S.init(SEQ, 41 * 256, G, bid); S.rep = REPG_P4;
        LAS float* rsl = (LAS float*)(lds + 131072); prep_rstd(S, NPA, rsl);
        pg8::EpiWin E{P, DT, VPART, rsl, HALO};
        pg8::gemm_phase<pg8::EpiWin, pg8::StaticOrder, true>(lds, g, S, E);
        { PHASE_IDS
            const int ntile = 32 * 41, full = (ntile + G - 1) / G, istart = ntile - (full - 1) * G; const bool all = istart >= G;
            __syncthreads();
            if (all || bid >= istart) CONVERT_RANGE(CV_P1_END, CV_P4_END, (all ? bid : bid - istart), (all ? G : G - istart)); }
    }
    GRID_SYNC(); STAMP(5);

    { PHASE_IDS
        const float* cw = ((const float*)inp[10]); const float* cb = ((const float*)inp[11]);
        const int ch = tid * 8;
        for (int rb = bid; rb < SEQ / 32; rb += G) {
            f32x4 w0[4], w1[4];
#pragma unroll
            for (int k = 0; k < 4; ++k) { w0[k] = *(const f32x4*)(cw + k * 4096 + ch); w1[k] = *(const f32x4*)(cw + k * 4096 + ch + 4); }
            const f32x4 b0 = *(const f32x4*)(cb + ch), b1 = *(const f32x4*)(cb + ch + 4);
            f32x4 xa[3], xb[3];
#pragma unroll
            for (int k = 0; k < 3; ++k) { u32x4 raw = {0u, 0u, 0u, 0u}; if (rb > 0) raw = *(const u32x4*)(HALO + ((size_t)(rb - 1) * 3 + k) * 4096 + ch);
                xa[k] = (f32x4){bflo(raw.x), bfhi(raw.x), bflo(raw.y), bfhi(raw.y)}; xb[k] = (f32x4){bflo(raw.z), bfhi(raw.z), bflo(raw.w), bfhi(raw.w)}; }
            bf16_t* pp = P + (size_t)(rb * 32) * PW + PX0 + ch;
#pragma unroll 8
            for (int r = 0; r < 32; ++r) { const u32x4 raw = *(const u32x4*)(pp + (size_t)r * PW);
                const f32x4 ca = {bflo(raw.x), bfhi(raw.x), bflo(raw.y), bfhi(raw.y)}, cbv = {bflo(raw.z), bfhi(raw.z), bflo(raw.w), bfhi(raw.w)};
                const f32x4 ya = b0 + w0[0] * xa[0] + w0[1] * xa[1] + w0[2] * xa[2] + w0[3] * ca, yb = b1 + w1[0] * xb[0] + w1[1] * xb[1] + w1[2] * xb[2] + w1[3] * cbv;
                u32x4 o; o.x = cvt_pk_bf16(silu_f(ya[0]), silu_f(ya[1])); o.y = cvt_pk_bf16(silu_f(ya[2]), silu_f(ya[3])); o.z = cvt_pk_bf16(silu_f(yb[0]), silu_f(yb[1])); o.w = cvt_pk_bf16(silu_f(yb[2]), silu_f(yb[3]));
                *(u32x4*)(pp + (size_t)r * PW) = o;
                xa[0] = xa[1]; xa[1] = xa[2]; xa[2] = ca; xb[0] = xb[1]; xb[1] = xb[2]; xb[2] = cbv; }
        }
    }
    { PHASE_IDS
        constexpr int GV0_OFF = 0, GV1_OFF = 128 * LP, AM_OFF = 2 * 128 * LP, RS_OFF = 3 * 128 * LP;
        LAS float* rs = (LAS float*)(lds + RS_OFF);
        const float* w_s = ((const float*)inp[8]); const float* b_s = ((const float*)inp[9]); const float* vnw = ((const float*)inp[7]);
        for (int unit = bid; unit < 64 * 4; unit += G) {
            const int c = unit >> 2, g = unit & 3, tok0 = c * 128;
            u32x4 rg[4];
#define GV_LOAD(DQ) do { _Pragma("unroll") for (int k = 0; k < 4; ++k) rg[k] = *(const u32x4*)(P + (size_t)(tok0 + (tid >> 4) + 32 * k) * PW + PV0 + g * 512 + (DQ) * 128 + (tid & 15) * 8); } while (0)
#define GV_SCATTER(BUF) do { _Pragma("unroll") for (int k = 0; k < 4; ++k) { LAS unsigned char* dst = lds + (BUF) + ((tid & 15) * 8) * LP + ((tid >> 4) + 32 * k) * 2; SCATTER8(dst, rg[k]); } } while (0)
            GV_LOAD(0);
            __syncthreads();
            if (tid < 128) { const f32x4* pp = (const f32x4*)(VPART + (size_t)(tok0 + tid) * 32); float sm = 0.f;
#pragma unroll
                for (int q = 0; q < 8; ++q) { const f32x4 t = pp[q]; sm += (t[0] + t[1]) + (t[2] + t[3]); }
                rs[tid] = rsqrtf(sm * (1.f / 2048.f) + EPS); }
            __syncthreads();
#pragma unroll
            for (int k = 0; k < 4; ++k) { const int t = (tid >> 4) + 32 * k, s8 = (tid & 15) * 8;
                const f32x4 w0 = *(const f32x4*)(w_s + ((size_t)g * 128 + t) * 128 + s8), w1 = *(const f32x4*)(w_s + ((size_t)g * 128 + t) * 128 + s8 + 4);
                float v[8] = {w0[0], w0[1], w0[2], w0[3], w1[0], w1[1], w1[2], w1[3]};
#pragma unroll
                for (int q = 0; q < 8; ++q) v[q] = (s8 + q <= t) ? v[q] * rs[s8 + q] : 0.f;
                *(LAS bf16x8*)(lds + AM_OFF + t * LP + s8 * 2) = pack8(v); }
            GV_SCATTER(GV0_OFF);
            GV_LOAD(1);
            __syncthreads();
#pragma unroll
            for (int dq = 0; dq < 4; ++dq) {
                const int gvb = (dq & 1) ? GV1_OFF : GV0_OFF, ch0 = g * 512 + dq * 128;
                u32x2 uu[8];
#pragma unroll
                for (int tt = 0; tt < 8; ++tt) uu[tt] = *(const u32x2*)(P + (size_t)(tok0 + tt * 16 + fr) * PW + PU0 + ch0 + 16 * wave + fq * 4);
                bf16x8 afr[4];
#pragma unroll
                for (int kk = 0; kk < 4; ++kk) afr[kk] = *(LAS bf16x8*)(lds + gvb + (16 * wave + fr) * LP + (kk * 32 + fq * 8) * 2);
                const f32x4 wv = *(const f32x4*)(vnw + ch0 + 16 * wave + fq * 4);
#pragma unroll
                for (int tt = 0; tt < 8; ++tt) { f32x4 acc = {0.f, 0.f, 0.f, 0.f};
#pragma unroll
                    for (int kk = 0; kk < 4; ++kk) if (kk <= tt / 2) { const bf16x8 bq = *(LAS bf16x8*)(lds + AM_OFF + (tt * 16 + fr) * LP + (kk * 32 + fq * 8) * 2); acc = MFMA16(afr[kk], bq, acc); }
                    const int t = tt * 16 + fr; const float bb = b_s[g * 128 + t];
                    bf16_t* up = P + (size_t)(tok0 + t) * PW + PU0 + ch0 + 16 * wave + fq * 4;
                    u32x2 o; o.x = cvt_pk_bf16(bflo(uu[tt].x) * (acc[0] * wv[0] + bb), bfhi(uu[tt].x) * (acc[1] * wv[1] + bb)); o.y = cvt_pk_bf16(bflo(uu[tt].y) * (acc[2] * wv[2] + bb), bfhi(uu[tt].y) * (acc[3] * wv[3] + bb));
                    *(u32x2*)up = o; }
                if (dq < 3) { GV_SCATTER((dq & 1) ? GV0_OFF : GV1_OFF); if (dq < 2) GV_LOAD(dq + 2); __syncthreads(); }
            }
#undef GV_LOAD
#undef GV_SCATTER
        }
    }
    GRID_SYNC(); STAMP(4);

    { PHASE_IDS
        constexpr int XT_OFF = 0, BP_OFF = 64 * LP, SC_OFF = BP_OFF + 128 * LP;
        LAS float* dtv = (LAS float*)(lds + SC_OFF); LAS float* cum = dtv + 128;
        const float* dtb = ((const float*)inp[12]); const float* alog = ((const float*)inp[13]);
        constexpr int NU = REPU_P5A * 64 * NHEAD;
        u32x4 rx[2], rb[4]; float rd0 = 0.f, rd1 = 0.f;
#define P5A_LOAD(UU) do { const int un_ = (UU) % (64 * NHEAD); const int h_ = un_ & 31, g_ = h_ >> 2, t_ = (un_ >> 5) * 128; \
            _Pragma("unroll") for (int k = 0; k < 2; ++k) rx[k] = *(const u32x4*)(P + (size_t)(t_ + (tid >> 3) + 64 * k) * PW + PX0 + h_ * 64 + (tid & 7) * 8); \
            _Pragma("unroll") for (int k = 0; k < 4; ++k) rb[k] = *(const u32x4*)(P + (size_t)(t_ + (tid >> 4) + 32 * k) * PW + PX0 + 2048 + g_ * 128 + (tid & 15) * 8); \
            rd0 = DT[(size_t)(t_ + 2 * lane) * 32 + h_]; rd1 = DT[(size_t)(t_ + 2 * lane + 1) * 32 + h_]; } while (0)
        int uu = bid;
        if (uu < NU) P5A_LOAD(uu);
        for (; uu < NU; uu += G) { const int unit = uu % (64 * NHEAD);
            const int c = unit >> 5, h = unit & 31;
            __syncthreads();
            if (wave == 0) dt_cum_r(rd0, rd1, h, dtb, alog, dtv, cum, lane);
#pragma unroll
            for (int k = 0; k < 2; ++k) { LAS unsigned char* dst = lds + XT_OFF + ((tid & 7) * 8) * LP + ((tid >> 3) + 64 * k) * 2; SCATTER8(dst, rx[k]); }
#pragma unroll
            for (int k = 0; k < 4; ++k) *(LAS u32x4*)(lds + BP_OFF + ((tid >> 4) + 32 * k) * LP + (tid & 15) * 16) = rb[k];
            if (uu + G < NU) P5A_LOAD(uu + G);
            __syncthreads();
            const float cl = cum[127];
            if (tid == 0) CDEC[c * 32 + h] = expf(cl);
            bf16x8 bfr[4];
#pragma unroll
            for (int kk = 0; kk < 4; ++kk) { bf16x8 t;
#pragma unroll
                for (int j = 0; j < 8; ++j) t[j] = (short)*(LAS unsigned short*)(lds + BP_OFF + (kk * 32 + fq * 8 + j) * LP + (16 * wave + fr) * 2);
                bfr[kk] = t; }
            float wl[4][8];
#pragma unroll
            for (int kk = 0; kk < 4; ++kk)
#pragma unroll
                for (int j = 0; j < 8; ++j) { const int l = kk * 32 + fq * 8 + j; wl[kk][j] = dtv[l] * __expf(cl - cum[l]); }
            float* stp = ST + ((size_t)(c * 32 + h) * 64) * 128;
#pragma unroll
            for (int pt = 0; pt < 4; ++pt) { f32x4 acc = {0.f, 0.f, 0.f, 0.f};
#pragma unroll
                for (int kk = 0; kk < 4; ++kk) { const bf16x8 raw = *(LAS bf16x8*)(lds + XT_OFF + (pt * 16 + fr) * LP + (kk * 32 + fq * 8) * 2); float v[8];
#pragma unroll
                    for (int j = 0; j < 8; ++j) v[j] = bf2f((unsigned short)raw[j]) * wl[kk][j];
                    acc = MFMA16(bfr[kk], pack8(v), acc); }
                *(f32x4*)(stp + (size_t)(pt * 16 + fr) * 128 + 16 * wave + fq * 4) = acc; }
        }
#undef P5A_LOAD
    }
    GRID_SYNC(); STAMP(6);

    { PHASE_IDS
        for (int e = bid * 512 + tid; e < NHEAD * 64 * 128 / 2; e += G * 512) {
            const int h = e / (64 * 128 / 2);
            f32x2 carry = {0.f, 0.f};
            f32x2* p = (f32x2*)ST + e;
#pragma unroll 8
            for (int c = 0; c < 64; ++c) { const f32x2 v = p[(size_t)c * (NHEAD * 64 * 128 / 2)]; const float d = CDEC[c * 32 + h]; p[(size_t)c * (NHEAD * 64 * 128 / 2)] = carry; carry = carry * d + v; }
        }
    }
    GRID_SYNC(); STAMP(7);

    { PHASE_IDS
        constexpr int XT_OFF = 0, BP_OFF = 64 * LP, CP_OFF = BP_OFF + 128 * LP, MM_OFF = CP_OFF + 128 * LP, SC_OFF = MM_OFF + 128 * LP, PV_OFF = SC_OFF + 1024;
        static_assert(PV_OFF + 64 * LP <= LDS_BYTES - 128, "P7 LDS map");
        LAS float* dtv = (LAS float*)(lds + SC_OFF); LAS float* cum = dtv + 128;
        const float* dskip = ((const float*)inp[14]); const float* snw = ((const float*)inp[15]);
        const float* dtb = ((const float*)inp[12]); const float* alog = ((const float*)inp[13]);
        constexpr int NU = 64 * 8;
        u32x4 rx[2], rbc[8]; f32x4 rp[4]; float rd0 = 0.f, rd1 = 0.f;
        const int bccol = ((tid & 31) < 16) ? (tid & 31) * 8 : 1024 + ((tid & 31) - 16) * 8;
#define P7_BC_LOAD(UN) do { const int g_ = (UN) & 7, t_ = ((UN) >> 3) * 128; \
            _Pragma("unroll") for (int k = 0; k < 8; ++k) rbc[k] = *(const u32x4*)(P + (size_t)(t_ + (tid >> 5) + 16 * k) * PW + PX0 + 2048 + g_ * 128 + bccol); } while (0)
#define P7_H_LOAD(UN, R) do { const int h_ = ((UN) & 7) * 4 + (R), c_ = (UN) >> 3, t_ = c_ * 128; \
            _Pragma("unroll") for (int k = 0; k < 2; ++k) rx[k] = *(const u32x4*)(P + (size_t)(t_ + (tid >> 3) + 64 * k) * PW + PX0 + h_ * 64 + (tid & 7) * 8); \
            _Pragma("unroll") for (int k = 0; k < 4; ++k) rp[k] = ((const f32x4*)(ST + (size_t)(c_ * 32 + h_) * 64 * 128))[tid + 512 * k]; \
            rd0 = DT[(size_t)(t_ + 2 * lane) * 32 + h_]; rd1 = DT[(size_t)(t_ + 2 * lane + 1) * 32 + h_]; } while (0)
#define P7_H_STAGE(H) do { if (wave == 0) dt_cum_r(rd0, rd1, (H), dtb, alog, dtv, cum, lane); \
            _Pragma("unroll") for (int k = 0; k < 2; ++k) { LAS unsigned char* dst = lds + XT_OFF + ((tid & 7) * 8) * LP + ((tid >> 3) + 64 * k) * 2; SCATTER8(dst, rx[k]); } \
            _Pragma("unroll") for (int k = 0; k < 4; ++k) { u32x2 o; o.x = cvt_pk_bf16(rp[k][0], rp[k][1]); o.y = cvt_pk_bf16(rp[k][2], rp[k][3]); \
                *(LAS u32x2*)(lds + PV_OFF + ((tid >> 5) + 16 * k) * LP + (tid & 31) * 8) = o; } } while (0)
        for (int unit = bid; unit < NU; unit += G) {
            const int c = unit >> 3, g = unit & 7, tok0 = c * 128;
            P7_BC_LOAD(unit); P7_H_LOAD(unit, 0);
            __syncthreads();
#pragma unroll
            for (int k = 0; k < 8; ++k) *(LAS u32x4*)(lds + ((tid & 31) < 16 ? BP_OFF + (tid & 31) * 16 : CP_OFF + ((tid & 31) - 16) * 16) + ((tid >> 5) + 16 * k) * LP) = rbc[k];
            P7_H_STAGE(4 * g);
            P7_H_LOAD(unit, 1);
            __syncthreads();
            bf16x8 cfr[4];
#pragma unroll
            for (int kk = 0; kk < 4; ++kk) cfr[kk] = *(LAS bf16x8*)(lds + CP_OFF + (16 * wave + fr) * LP + (kk * 32 + fq * 8) * 2);
            const int l = 16 * wave + fr; const int tok = tok0 + l;
            f32x4 sacc[8];
#pragma unroll
            for (int st = 0; st < 8; ++st) { f32x4 acc = {0.f, 0.f, 0.f, 0.f};
                if (st <= wave) {
#pragma unroll
                for (int kk = 0; kk < 4; ++kk) { const bf16x8 a = *(LAS bf16x8*)(lds + BP_OFF + (st * 16 + fr) * LP + (kk * 32 + fq * 8) * 2); acc = MFMA16(a, cfr[kk], acc); } }
                sacc[st] = acc; }
#pragma unroll
            for (int r = 0; r < 4; ++r) { const int h = 4 * g + r;
                if (r > 0) { __syncthreads(); P7_H_STAGE(h);
                    if (r < 3) P7_H_LOAD(unit, r + 1);
                    __syncthreads(); }
                const float cl = cum[l];
#pragma unroll
                for (int st = 0; st < 8; ++st) { float mv[4];
#pragma unroll
                    for (int j = 0; j < 4; ++j) { const int sx = st * 16 + fq * 4 + j; mv[j] = (sx <= l) ? sacc[st][j] * __expf(cl - cum[sx]) * dtv[sx] : 0.f; }
                    u32x2 o; o.x = cvt_pk_bf16(mv[0], mv[1]); o.y = cvt_pk_bf16(mv[2], mv[3]);
                    *(LAS u32x2*)(lds + MM_OFF + l * LP + (st * 16 + fq * 4) * 2) = o; }
                asm volatile("s_waitcnt lgkmcnt(0)" ::: "memory");
                bf16x8 mfr[4];
#pragma unroll
                for (int kk = 0; kk < 4; ++kk) mfr[kk] = *(LAS bf16x8*)(lds + MM_OFF + l * LP + (kk * 32 + fq * 8) * 2);
                const float ecl = __expf(cl), dsk = dskip[h];
                float ss = 0.f;
#pragma unroll
                for (int pt = 0; pt < 4; ++pt) { f32x4 ad = {0.f, 0.f, 0.f, 0.f}, ao = {0.f, 0.f, 0.f, 0.f};
#pragma unroll
                    for (int kk = 0; kk < 4; ++kk) { if (kk <= (wave >> 1)) { const bf16x8 a = *(LAS bf16x8*)(lds + XT_OFF + (pt * 16 + fr) * LP + (kk * 32 + fq * 8) * 2); ad = MFMA16(a, mfr[kk], ad); }
                        const bf16x8 pa = *(LAS bf16x8*)(lds + PV_OFF + (pt * 16 + fr) * LP + (kk * 32 + fq * 8) * 2); ao = MFMA16(pa, cfr[kk], ao); }
                    const int p0i = pt * 16 + fq * 4;
                    bf16_t* zp = P + (size_t)tok * PW + PZ0 + h * 64 + p0i;
                    const u32x2 zz = *(const u32x2*)zp; const float zf[4] = {bflo(zz.x), bfhi(zz.x), bflo(zz.y), bfhi(zz.y)};
                    const f32x4 nw = *(const f32x4*)(snw + h * 64 + p0i);
                    float yv[4];
#pragma unroll
                    for (int j = 0; j < 4; ++j) { const float xv = bf2f(*(LAS unsigned short*)(lds + XT_OFF + (p0i + j) * LP + l * 2));
                        const float y = (ad[j] + ecl * ao[j] + dsk * xv) * zf[j]; ss += y * y; yv[j] = y * nw[j]; }
                    u32x2 o; o.x = cvt_pk_bf16(yv[0], yv[1]); o.y = cvt_pk_bf16(yv[2], yv[3]);
                    *(u32x2*)zp = o; }
                ss += __shfl_xor(ss, 16); ss += __shfl_xor(ss, 32);
                if (fq == 0) YPART[(size_t)tok * 32 + h] = ss;
            }
        }
#undef P7_BC_LOAD
#undef P7_H_LOAD
#undef P7_H_STAGE
    }
    GRID_SYNC(); STAMP(8);

    {
        pg8::StaticOrder S; S.init(SEQ, DM, G, bid);
        const CAS gfptr* inp = (const CAS gfptr*)__builtin_amdgcn_kernarg_segment_ptr();
        LAS float* rsl = (LAS float*)(lds + 131072); prep_rstd(S, YPART, rsl);
        pg8::Gemm g{P + PZ0, WOUTA, SEQ, DM, 2 * DM, PW, 32, (long)(PU0 - PZ0 - DM) * 2};
        pg8::EpiResidMid E; E.base = HB; E.out = HB; E.ldc = DM; E.alpha = 1.0f; E.part = nullptr; E.xn = XN; E.nw = ((const float*)inp[17]); E.npart = NPB; E.rsl = rsl;
        pg8::gemm_phase<pg8::EpiResidMid, pg8::StaticOrder, true>(lds, g, S, E);
    }
    GRID_SYNC(); STAMP(9);


    {
        pg8::Gemm g{XN, WQ, SEQ, DM, DM, DM}; pg8::StaticOrder S; S.init(SEQ, DM, G, bid);
        LAS float* rsl = (LAS float*)(lds + 131072); prep_rstd(S, NPB, rsl);
        pg8::EpiBf16 E{QB, DM, 0.044194173824159216f, rsl};
        pg8::gemm_phase<pg8::EpiBf16, pg8::StaticOrder, true>(lds, g, S, E);
    }
    GRID_SYNC(); STAMP(11);

    { PHASE_IDS
        constexpr int KP = 272, VP = 528, PP = 528, PBUF = 69632;
        LAS unsigned char* pw = lds + PBUF + wave * 8448;
        for (int uu = bid; uu < REPU_P11 * 64 * 4; uu += G) { const int unit = uu % (64 * 4);
            const int tb = unit >> 2, h = unit & 3, t0 = tb * 128 + 16 * wave;
            __syncthreads();
            u32x4 stg[8];
#define LOADK(c) do { _Pragma("unroll") for (int i = 0; i < 8; ++i) stg[i] = *(const u32x4*)(KB + (size_t)((tid >> 4) + 32 * i) * DM + h * 512 + (c) * 128 + (tid & 15) * 8); } while (0)
#define STOREK() do { _Pragma("unroll") for (int i = 0; i < 8; ++i) *(LAS u32x4*)(lds + ((tid >> 4) + 32 * i) * KP + (tid & 15) * 16) = stg[i]; } while (0)
#define LOADV(v) do { _Pragma("unroll") for (int i = 0; i < 8; ++i) stg[i] = *(const u32x4*)(VT + (size_t)(h * 512 + (v) * 128 + (tid >> 5) + 16 * i) * 256 + (tid & 31) * 8); } while (0)
#define STOREV() do { _Pragma("unroll") for (int i = 0; i < 8; ++i) *(LAS u32x4*)(lds + ((tid >> 5) + 16 * i) * VP + (tid & 31) * 16) = stg[i]; } while (0)
            LOADK(0);
            bf16x8 qf[16];
#pragma unroll
            for (int kk = 0; kk < 16; ++kk) qf[kk] = *(const bf16x8*)(QB + (size_t)(t0 + fr) * DM + h * 512 + kk * 32 + fq * 8);
            STOREK();
            __syncthreads();
            f32x4 sacc[16];
#pragma unroll
            for (int mt = 0; mt < 16; ++mt) sacc[mt] = (f32x4){0.f, 0.f, 0.f, 0.f};
#pragma unroll
            for (int c = 0; c < 4; ++c) {
                if (c < 3) LOADK(c + 1); else LOADV(0);
#pragma unroll
                for (int mt = 0; mt < 16; ++mt)
#pragma unroll
                    for (int kk = 0; kk < 4; ++kk) { const bf16x8 a = *(LAS bf16x8*)(lds + (mt * 16 + fr) * KP + (kk * 32 + fq * 8) * 2); sacc[mt] = MFMA16(a, qf[c * 4 + kk], sacc[mt]); }
                __syncthreads();
                if (c < 3) STOREK(); else STOREV();
                __syncthreads();
            }
            float mx = -3.0e38f;
#pragma unroll
            for (int mt = 0; mt < 16; ++mt)
#pragma unroll
                for (int j = 0; j < 4; ++j) mx = fmaxf(mx, sacc[mt][j]);
            mx = fmaxf(mx, __shfl_xor(mx, 16)); mx = fmaxf(mx, __shfl_xor(mx, 32));
            float sum = 0.f;
#pragma unroll
            for (int mt = 0; mt < 16; ++mt)
#pragma unroll
                for (int j = 0; j < 4; ++j) { const float e = __expf(sacc[mt][j] - mx); sacc[mt][j] = e; sum += e; }
            sum += __shfl_xor(sum, 16); sum += __shfl_xor(sum, 32);
            const float inv = 1.0f / sum;
#pragma unroll
            for (int mt = 0; mt < 16; ++mt) { u32x2 o; o.x = cvt_pk_bf16(sacc[mt][0] * inv, sacc[mt][1] * inv); o.y = cvt_pk_bf16(sacc[mt][2] * inv, sacc[mt][3] * inv);
                *(LAS u32x2*)(pw + fr * PP + (mt * 16 + fq * 4) * 2) = o; }
            asm volatile("s_waitcnt lgkmcnt(0)" ::: "memory");
            bf16x8 pf[8];
#pragma unroll
            for (int kk = 0; kk < 8; ++kk) pf[kk] = *(LAS bf16x8*)(pw + fr * PP + (kk * 32 + fq * 8) * 2);
#pragma unroll
            for (int v = 0; v < 4; ++v) {
                if (v < 3) LOADV(v + 1);
#pragma unroll
                for (int dt = 0; dt < 8; ++dt) { f32x4 acc = {0.f, 0.f, 0.f, 0.f};
#pragma unroll
                    for (int kk = 0; kk < 8; ++kk) { const bf16x8 a = *(LAS bf16x8*)(lds + (dt * 16 + fr) * VP + (kk * 32 + fq * 8) * 2); acc = MFMA16(a, pf[kk], acc); }
                    u32x2 o; o.x = cvt_pk_bf16(acc[0], acc[1]); o.y = cvt_pk_bf16(acc[2], acc[3]);
                    *(u32x2*)(OB + (size_t)(t0 + fr) * DM + h * 512 + v * 128 + dt * 16 + fq * 4) = o; }
                if (v < 3) { __syncthreads(); STOREV(); __syncthreads(); }
            }
#undef LOADK
#undef STOREK
#undef LOADV
#undef STOREV
        }
    }
    GRID_SYNC(); STAMP(12);

    {
        pg8::Gemm g{OB, WO, SEQ, DM, DM, DM}; pg8::StaticOrder S; S.init(SEQ, DM, G, bid);
        const CAS gfptr* inp = (const CAS gfptr*)__builtin_amdgcn_kernarg_segment_ptr();
        pg8::EpiResid<false> E{HB, HB, DM, 1.0f, nullptr, XN, ((const float*)inp[22]), NPC};
        pg8::gemm_phase<pg8::EpiResid<false>, pg8::StaticOrder, true>(lds, g, S, E);
    }
    GRID_SYNC(); STAMP(13);


    {
        pg8::Gemm g{XN, WGU2, SEQ, 2 * DFF, DM, DM}; pg8::StaticOrder S; S.init(SEQ, 2 * DFF, G, bid);
        LAS float* rsl = (LAS float*)(lds + 131072); prep_rstd(S, NPC, rsl);
        pg8::EpiSwiGLU E{ACT2, DFF, rsl};
        pg8::gemm_phase<pg8::EpiSwiGLU, pg8::StaticOrder, true>(lds, g, S, E);
        { PHASE_IDS
            const int ntile = 32 * 44, full = (ntile + G - 1) / G, istart = ntile - (full - 1) * G; const bool all = istart >= G;
            __syncthreads();
            if (all || bid >= istart) CONVERT_RANGE(CV_P4_END, CV_END, (all ? bid : bid - istart), (all ? G : G - istart)); }
    }
    GRID_SYNC(); STAMP(15);

    if (G == 256) {
        const CAS gfptr* inp = (const CAS gfptr*)__builtin_amdgcn_kernarg_segment_ptr();
        pg8::Gemm g{ACT2, WD2, SEQ, DM, DFF, DFF}; pg8::StaticOrder S; S.init(SEQ, DM, G, bid);
        pg8::EpiFinal E{HB, args.out, DM, 0.5f, ((const float*)inp[25]), (float*)(ws + 65536), (unsigned*)(ws + 16384), (LAS float*)(lds + 131072)};
        pg8::gemm_phase<pg8::EpiFinal, pg8::StaticOrder, true>(lds, g, S, E);
    } else {
        {
            pg8::Gemm g{ACT2, WD2, SEQ, DM, DFF, DFF}; pg8::StaticOrder S; S.init(SEQ, DM, G, bid);
            pg8::EpiResid<false> E{HB, HB, DM, 0.5f, nullptr, nullptr, nullptr, nullptr};
            pg8::gemm_phase<pg8::EpiResid<false>, pg8::StaticOrder, true>(lds, g, S, E);
        }
        GRID_SYNC(); STAMP(16);
        { PHASE_IDS
        for (int m = gw; m < SEQ; m += NGW) norm_row_from_bf16(HB + (size_t)m * DM, ((const float*)inp[25]), args.out + (size_t)m * DM, lane);
        }
    }
}

extern "C" void kernel_launch(void* const* d_in, const int* in_sizes, int n_in, void* d_out, int out_size, void* d_ws, size_t ws_size, hipStream_t stream) {
    static int grid = 0;
    if (grid == 0) {
        if (n_in != 26 || out_size != SEQ * DM || ws_size < WS_END) { fprintf(stderr, "kernel_launch: unexpected shapes (n_in %d out %d ws %zu)\n", n_in, out_size, ws_size); grid = -1; return; }
        int dev = 0, cus = 0, per_cu = 0;
        if (hipGetDevice(&dev) != hipSuccess || hipDeviceGetAttribute(&cus, hipDeviceAttributeMultiprocessorCount, dev) != hipSuccess) { grid = -1; return; }
        if (hipFuncSetAttribute((const void*)mega_fwd, hipFuncAttributeMaxDynamicSharedMemorySize, LDS_BYTES) != hipSuccess) { fprintf(stderr, "kernel_launch: hipFuncSetAttribute failed\n"); grid = -1; return; }
        if (hipOccupancyMaxActiveBlocksPerMultiprocessor(&per_cu, (const void*)mega_fwd, 512, LDS_BYTES) != hipSuccess || per_cu < 1) { fprintf(stderr, "kernel_launch: occupancy query failed (%d)\n", per_cu); (void)hipGetLastError(); per_cu = 1; }
        grid = cus * (per_cu < 1 ? 1 : 1);
    }
    if (grid < 0) return;
    if (hipMemsetAsync(d_ws, 0, 32768, stream) != hipSuccess) { fprintf(stderr, "kernel_launch: memset failed\n"); return; }
    Args a{};
    for (int i = 0; i < 26; ++i) a.in[i] = (const float*)d_in[i];
    a.out = (float*)d_out; a.ws = (unsigned char*)d_ws;
    void* kargs[] = {&a};
    hipError_t e = hipLaunchCooperativeKernel((const void*)mega_fwd, dim3(grid), dim3(512), kargs, LDS_BYTES, stream);
    if (e != hipSuccess) fprintf(stderr, "cooperative launch failed: %s (grid %d)\n", hipGetErrorString(e), grid);
}
```

```cpp
#include <hip/hip_runtime.h>
#include <hip/hip_cooperative_groups.h>
#include <cstdio>
#include <cstdint>
namespace cg = cooperative_groups;

#define LAS __attribute__((address_space(3)))
#define CAS __attribute__((address_space(4)))
typedef const __attribute__((address_space(1))) float* gfptr;
typedef unsigned short bf16_t;
typedef short bf16x8 __attribute__((ext_vector_type(8)));
typedef float f32x4 __attribute__((ext_vector_type(4)));
typedef float f32x2 __attribute__((ext_vector_type(2)));
typedef unsigned u32x4 __attribute__((ext_vector_type(4)));
typedef unsigned u32x2 __attribute__((ext_vector_type(2)));

constexpr int SEQ = 8192, DM = 2048, DFF = 5632, MEML = 256;
constexpr int NHEAD = 32, PW = 10240;
constexpr int PU0 = 0, PZ0 = 2048, PV0 = 4096, PX0 = 6144;
constexpr float EPS = 1e-6f;

constexpr size_t MiB = 1u << 20;
constexpr size_t WS_WGU1 = 1 * MiB, WS_WD1 = 45 * MiB, WS_WIN = 67 * MiB, WS_WOUTA = 108 * MiB, WS_WOUTM = 116 * MiB,
                 WS_WQ = 124 * MiB, WS_WKV = 132 * MiB, WS_WO = 148 * MiB, WS_WGU2 = 156 * MiB, WS_WD2 = 200 * MiB,
                 WS_XN = 222 * MiB, WS_P = 254 * MiB, WS_ST = 414 * MiB, WS_DT = 478 * MiB, WS_VPART = 479 * MiB,
                 WS_YPART = 480 * MiB, WS_CDEC = 481 * MiB, WS_KB = 482 * MiB, WS_VT = 483 * MiB, WS_MEMN = 484 * MiB,
                 WS_HALO = 489 * MiB, WS_NPA = 485 * MiB, WS_NPB = 486 * MiB, WS_NPC = 487 * MiB, WS_NPD = 488 * MiB,
                 WS_END = 495 * MiB;
constexpr size_t WS_ACT = WS_P;
constexpr size_t WS_Q = WS_P, WS_O = WS_P + 32 * MiB, WS_ACT2 = WS_P + 64 * MiB;

constexpr int LDS_BYTES = 147456;
#ifndef PROBE_A
#define PROBE_A -1
#define PROBE_B -1
#endif
#ifndef REP_P0
#define REPU_P5A 1
#define REPU_P7 1
#define REPU_P5B 1
#define REPU_P11 1
#define REPG_P4 1
#define REPG_P2 1
#define REP_SYNC 1
#endif
#ifndef STOP_AFTER
#define STOP_AFTER 99
#endif

typedef __bf16 bf16x2_t __attribute__((ext_vector_type(2)));
__device__ __forceinline__ unsigned cvt_pk_bf16(float lo, float hi) { typedef float f2 __attribute__((ext_vector_type(2))); f2 v = {lo, hi}; bf16x2_t b = __builtin_convertvector(v, bf16x2_t); return __builtin_bit_cast(unsigned, b); }
__device__ __forceinline__ float bflo(unsigned u) { return __uint_as_float(u << 16); }
__device__ __forceinline__ float bfhi(unsigned u) { return __uint_as_float(u & 0xffff0000u); }
__device__ __forceinline__ float bf2f(unsigned short h) { return __uint_as_float(((unsigned)h) << 16); }
__device__ __forceinline__ float silu_f(float x) { return x * __builtin_amdgcn_rcpf(1.0f + __expf(-x)); }
__device__ __forceinline__ float gelu_f(float x) { const float y = 0.7978845608028654f * (x + 0.044715f * x * x * x); return x * __builtin_amdgcn_rcpf(1.0f + __expf(-2.0f * y)); }
__device__ __forceinline__ float wave_sum(float v) {
#pragma unroll
    for (int o = 1; o < 64; o <<= 1) v += __shfl_xor(v, o);
    return v;
}
__device__ __forceinline__ bf16x8 pack8(const float (&v)[8]) {
    u32x4 w; w.x = cvt_pk_bf16(v[0], v[1]); w.y = cvt_pk_bf16(v[2], v[3]); w.z = cvt_pk_bf16(v[4], v[5]); w.w = cvt_pk_bf16(v[6], v[7]);
    return __builtin_bit_cast(bf16x8, w);
}

namespace pg8 {
constexpr int BM = 256, BK = 64, HALF = 128, HTB = HALF * BK * 2, STAGE_BYTES = 8 * HTB, NXCD = 8, WGM = 8;
__host__ __device__ __forceinline__ int lds_byte(int r, int c) { const int st = (r >> 4) * 2 + (c >> 5), rr = r & 15, cc = c & 31, ob = rr * 64 + cc * 2; return st * 1024 + (ob ^ (((ob >> 9) & 1) << 5)); }
__host__ __device__ __forceinline__ void stage_rc(int b, int& R, int& C) { const int st = b / 1024, sb = b % 1024, swz = sb ^ (((sb >> 9) & 1) << 5); R = (st >> 1) * 16 + swz / 64; C = (st & 1) * 32 + (swz % 64) / 2; }
__host__ __device__ __forceinline__ int perm32(int rho) { const int n = rho >> 4, i = rho & 15; return 8 * (i >> 2) + 4 * n + (i & 3); }

struct Unit { int pm, pn; };
struct Gemm { const bf16_t* A; const bf16_t* Bt; int M, N, K, lda; int ks = 1 << 30; long ashift = 0; };

struct StaticOrder {
    int nM, nN, nwg, G, c, rep = 1;
    __host__ __device__ void init(int M, int N, int G_, int c_) { nM = M / BM; nN = N / BM; nwg = nM * nN; G = G_; c = c_; }
    __host__ __device__ bool next(int i, Unit& u) const {
        const long L = (long)i * G + c; if (L >= (long)nwg * rep) return false;
        int wgid = (int)L; if (rep > 1) { while (wgid >= nwg) wgid -= nwg; } { const int q = nwg / NXCD, r = nwg % NXCD, xcd = wgid % NXCD, off = wgid / NXCD; wgid = (xcd < r ? xcd * (q + 1) : r * (q + 1) + (xcd - r) * q) + off; }
        const int nig = WGM * nN, gid = wgid / nig, fm = gid * WGM, gsz = (nM - fm) < WGM ? (nM - fm) : WGM;
        u.pm = fm + ((wgid % nig) % gsz); u.pn = (wgid % nig) / gsz; return true;
    }
};

template <class Epi, class Sched, bool ALIGN_EPI>
__device__ __forceinline__ void gemm_phase(LAS unsigned char* lds, const Gemm g, const Sched& S, const Epi& E) {
    int tid = threadIdx.x; asm volatile("" : "+v"(tid));
    const int wid = __builtin_amdgcn_readfirstlane(tid >> 6), lane = tid & 63, wr = wid >> 2, wc = wid & 3, fr = lane & 15, fq = lane >> 4;
    const int K = g.K, nt = K / BK, lda = g.lda;
    unsigned voffA[2], voffB[2];
#pragma unroll
    for (int i = 0; i < 2; ++i) { int R, C; stage_rc(tid * 16 + i * 8192, R, C); const int Rb = Epi::PERM ? ((R & ~31) + perm32(R & 31)) : R;
        voffA[i] = (unsigned)(R * lda + C) * 2u; voffB[i] = (unsigned)(Rb * K + C) * 2u; }
    const size_t kstep = (size_t)(BK * 2);
    const size_t hstepA = (size_t)HALF * lda * 2, hstepB = (size_t)HALF * K * 2;
    const size_t tstepA = 2 * hstepA, tstepB = 2 * hstepB;
    const unsigned ldsw = (unsigned)wid * 1024u;
    const int aoff = lds_byte(wr * 64 + fr, fq * 8), boff = lds_byte(wc * 32 + fr, fq * 8);
#define PG8_SA(b, h) (((b) * 2 + (h)) * HTB)
#define PG8_SB(b, h) ((4 + (b) * 2 + (h)) * HTB)
#define PG8_STAGE(bufoff, gbase, voff) do { _Pragma("unroll") for (int _i = 0; _i < 2; ++_i) \
        __builtin_amdgcn_global_load_lds((const unsigned*)((const char*)(gbase) + (voff)[_i]), (LAS unsigned*)(lds + (bufoff) + ldsw + _i * 8192), 16, 0, 0); } while (0)
#define PG8_LDA(dst, b, h) do { _Pragma("unroll") for (int m = 0; m < 4; ++m) _Pragma("unroll") for (int k = 0; k < 2; ++k) dst[m][k] = *(const LAS bf16x8*)(lds + PG8_SA(b, h) + aoff + m * 2048 + k * 1024); } while (0)
#define PG8_LDB(dst, b, h) do { _Pragma("unroll") for (int n = 0; n < 2; ++n) _Pragma("unroll") for (int k = 0; k < 2; ++k) dst[n][k] = *(const LAS bf16x8*)(lds + PG8_SB(b, h) + boff + n * 2048 + k * 1024); } while (0)
#define PG8_MMA(ai, bj, At, Bt) do { __builtin_amdgcn_s_setprio(1); _Pragma("unroll") for (int m = 0; m < 4; ++m) _Pragma("unroll") for (int n = 0; n < 2; ++n) _Pragma("unroll") for (int k = 0; k < 2; ++k) \
        acc[ai][bj][m][n] = __builtin_amdgcn_mfma_f32_16x16x32_bf16(Bt[n][k], At[m][k], acc[ai][bj][m][n], 0, 0, 0); __builtin_amdgcn_s_setprio(0); } while (0)
#define PG8_WAIT_V(n) asm volatile("s_waitcnt vmcnt(" #n ")" ::: "memory")
#define PG8_WAIT_L(n) asm volatile("s_waitcnt lgkmcnt(" #n ")" ::: "memory")
#define PG8_BAR __builtin_amdgcn_s_barrier()
#define PG8_SCHED __builtin_amdgcn_sched_barrier(0)
    Unit cur, nxt; int ui = 0;
    if (!S.next(0, cur)) return;
    f32x4 acc[2][2][4][2];
#pragma unroll
    for (int a = 0; a < 2; ++a)
#pragma unroll
        for (int b = 0; b < 2; ++b)
#pragma unroll
            for (int m = 0; m < 4; ++m)
#pragma unroll
                for (int n = 0; n < 2; ++n) acc[a][b][m][n] = (f32x4){0.f, 0.f, 0.f, 0.f};
    bf16x8 At[4][2], B0[2][2], B1[2][2];
    const char* cA = (const char*)g.A + (size_t)cur.pm * tstepA; const char* cB = (const char*)g.Bt + (size_t)cur.pn * tstepB;
    PG8_STAGE(PG8_SB(0, 0), cB, voffB); PG8_STAGE(PG8_SB(0, 1), cB + hstepB, voffB); PG8_STAGE(PG8_SA(0, 0), cA, voffA); PG8_STAGE(PG8_SA(0, 1), cA + hstepA, voffA);
    if (wr == 1) PG8_BAR;
    PG8_WAIT_V(2); PG8_BAR;
    PG8_STAGE(PG8_SB(1, 0), cB + kstep, voffB); PG8_STAGE(PG8_SA(1, 0), cA + kstep, voffA); PG8_STAGE(PG8_SB(1, 1), cB + hstepB + kstep, voffB);
    PG8_WAIT_V(6); PG8_BAR;
    for (;;) {
        const bool has_next = S.next(ui + 1, nxt);
        const char* nA = has_next ? (const char*)g.A + (size_t)nxt.pm * tstepA : cA; const char* nB = has_next ? (const char*)g.Bt + (size_t)nxt.pn * tstepB : cB;
        for (int t = 0; t < nt; t += 2) {
            const bool last = (t == nt - 2);
            if constexpr (Epi::MIDK) { if (t == g.ks) E.mid(acc, cur, ui, wr, wc, fr, fq); }
            const long sh1 = (t >= g.ks) ? g.ashift : 0, sh2 = (t + 2 >= g.ks) ? g.ashift : 0;
            const char* a1 = cA + (size_t)(t + 1) * kstep + sh1;
            const char* a2 = last ? nA : cA + (size_t)(t + 2) * kstep + sh2; const char* b2 = last ? nB : cB + (size_t)(t + 2) * kstep;
            const char* a3 = a2 + kstep; const char* b3 = b2 + kstep;
            PG8_LDB(B0, 0, 0); PG8_LDB(B1, 0, 1); PG8_SCHED; PG8_LDA(At, 0, 0); PG8_STAGE(PG8_SA(1, 1), a1 + hstepA, voffA);
            PG8_WAIT_V(8); PG8_WAIT_L(0); PG8_BAR; PG8_MMA(0, 0, At, B0); PG8_MMA(0, 1, At, B1); PG8_BAR; PG8_SCHED;
            PG8_LDA(At, 0, 1); PG8_STAGE(PG8_SB(0, 0), b2, voffB); PG8_STAGE(PG8_SB(0, 1), b2 + hstepB, voffB); PG8_STAGE(PG8_SA(0, 0), a2, voffA);
            PG8_WAIT_V(8); PG8_WAIT_L(0); PG8_BAR; PG8_MMA(1, 0, At, B0); PG8_MMA(1, 1, At, B1); PG8_BAR; PG8_SCHED;
            PG8_LDB(B0, 1, 0); PG8_LDB(B1, 1, 1); PG8_SCHED; PG8_LDA(At, 1, 0); PG8_STAGE(PG8_SA(0, 1), a2 + hstepA, voffA);
            PG8_WAIT_V(8); PG8_WAIT_L(0); PG8_BAR; PG8_MMA(0, 0, At, B0); PG8_MMA(0, 1, At, B1); PG8_BAR; PG8_SCHED;
            PG8_LDA(At, 1, 1); PG8_STAGE(PG8_SB(1, 0), b3, voffB); PG8_STAGE(PG8_SB(1, 1), b3 + hstepB, voffB); PG8_STAGE(PG8_SA(1, 0), a3, voffA);
            PG8_WAIT_V(8); PG8_WAIT_L(0); PG8_BAR; PG8_MMA(1, 0, At, B0); PG8_MMA(1, 1, At, B1); PG8_BAR; PG8_SCHED;
        }
        if constexpr (ALIGN_EPI) { if (wr == 0) PG8_BAR; }
        E(acc, cur, ui, wr, wc, fr, fq);
        if (!has_next) break;
#pragma unroll
        for (int a = 0; a < 2; ++a)
#pragma unroll
            for (int b = 0; b < 2; ++b)
#pragma unroll
                for (int m = 0; m < 4; ++m)
#pragma unroll
                    for (int n = 0; n < 2; ++n) acc[a][b][m][n] = (f32x4){0.f, 0.f, 0.f, 0.f};
        cur = nxt; cA = nA; cB = nB; ++ui;
        if constexpr (ALIGN_EPI) { if (wr == 1) PG8_BAR; }
    }
    PG8_WAIT_V(0);
    if constexpr (!ALIGN_EPI) { if (wr == 0) PG8_BAR; }
    PG8_BAR;
#undef PG8_SA
#undef PG8_SB
#undef PG8_STAGE
#undef PG8_LDA
#undef PG8_LDB
#undef PG8_MMA
#undef PG8_WAIT_V
#undef PG8_WAIT_L
#undef PG8_BAR
#undef PG8_SCHED
}

__device__ __forceinline__ float row_rstd(const float* part, int row, int fq) {
    const f32x4 p0 = *(const f32x4*)(part + (size_t)row * 32 + fq * 8), p1 = *(const f32x4*)(part + (size_t)row * 32 + fq * 8 + 4);
    float s = (p0[0] + p0[1]) + (p0[2] + p0[3]) + (p1[0] + p1[1]) + (p1[2] + p1[3]); s += __shfl_xor(s, 16); s += __shfl_xor(s, 32);
    return rsqrtf(s * (1.0f / 2048.0f) + EPS);
}
struct EpiSwiGLU {
    static constexpr bool PERM = true, MIDK = false;
    bf16_t* O; int ldc; const LAS float* rsl;
    __device__ __forceinline__ void operator()(const f32x4 (&acc)[2][2][4][2], const Unit& u, int ui, int wr, int wc, int fr, int fq) const {
        const int row0 = u.pm * BM + wr * 64 + fr, col0 = u.pn * HALF + wc * 32 + 8 * fq;
#pragma unroll
        for (int ai = 0; ai < 2; ++ai)
#pragma unroll
            for (int m = 0; m < 4; ++m) {
                const int row = row0 + ai * HALF + m * 16;
                bf16_t* rowp = O + (size_t)row * ldc + col0;
                const float rs = rsl[ui * 256 + (row & 255)];
                float v[8];
#pragma unroll
                for (int n = 0; n < 2; ++n)
#pragma unroll
                    for (int j = 0; j < 4; ++j) v[n * 4 + j] = silu_f(acc[ai][0][m][n][j] * rs) * (acc[ai][1][m][n][j] * rs);
                u32x4 w; w.x = cvt_pk_bf16(v[0], v[1]); w.y = cvt_pk_bf16(v[2], v[3]); w.z = cvt_pk_bf16(v[4], v[5]); w.w = cvt_pk_bf16(v[6], v[7]);
                *(u32x4*)rowp = w;
            }
    }
};
template <bool BASE_F32> struct EpiResid {
    static constexpr bool PERM = true, MIDK = false;
    const void* base; bf16_t* out; int ldc; float alpha; const float* part;
    bf16_t* xn; const float* nw; float* npart;
    __device__ __forceinline__ void operator()(const f32x4 (&acc)[2][2][4][2], const Unit& u, int ui, int wr, int wc, int fr, int fq) const {
        const int col0 = u.pn * BM + wc * 32 + 8 * fq;
#pragma unroll
        for (int ai = 0; ai < 2; ++ai)
#pragma unroll
            for (int m = 0; m < 4; ++m) {
                const int row = u.pm * BM + ai * HALF + wr * 64 + m * 16 + fr;
                float sc = alpha;
                if (part) sc = alpha * row_rstd(part, row, fq);
                const size_t off = (size_t)row * ldc + col0;
                float ss = 0.f;
#pragma unroll
                for (int bj = 0; bj < 2; ++bj) { f32x4 b0, b1;
                    if (BASE_F32) { b0 = *(const f32x4*)((const float*)base + off + bj * HALF); b1 = *(const f32x4*)((const float*)base + off + bj * HALF + 4); }
                    else { const u32x4 r = *(const u32x4*)((const bf16_t*)base + off + bj * HALF); b0 = (f32x4){bflo(r.x), bfhi(r.x), bflo(r.y), bfhi(r.y)}; b1 = (f32x4){bflo(r.z), bfhi(r.z), bflo(r.w), bfhi(r.w)}; }
                    const f32x4 o0 = b0 + acc[ai][bj][m][0] * sc, o1 = b1 + acc[ai][bj][m][1] * sc;
                    u32x4 ho; ho.x = cvt_pk_bf16(o0[0], o0[1]); ho.y = cvt_pk_bf16(o0[2], o0[3]); ho.z = cvt_pk_bf16(o1[0], o1[1]); ho.w = cvt_pk_bf16(o1[2], o1[3]);
                    *(u32x4*)(out + off + bj * HALF) = ho;
                    if (npart) ss += ((o0[0] * o0[0] + o0[1] * o0[1]) + (o0[2] * o0[2] + o0[3] * o0[3])) + ((o1[0] * o1[0] + o1[1] * o1[1]) + (o1[2] * o1[2] + o1[3] * o1[3]));
                    if (xn) { const f32x4 w0 = *(const f32x4*)(nw + col0 + bj * HALF), w1 = *(const f32x4*)(nw + col0 + bj * HALF + 4);
                        u32x4 q; q.x = cvt_pk_bf16(o0[0] * w0[0], o0[1] * w0[1]); q.y = cvt_pk_bf16(o0[2] * w0[2], o0[3] * w0[3]); q.z = cvt_pk_bf16(o1[0] * w1[0], o1[1] * w1[1]); q.w = cvt_pk_bf16(o1[2] * w1[2], o1[3] * w1[3]);
                        *(u32x4*)(xn + off + bj * HALF) = q; } }
                if (npart) { ss += __shfl_xor(ss, 16); ss += __shfl_xor(ss, 32); if (fq == 0) npart[(size_t)row * 32 + u.pn * 4 + wc] = ss; }
            }
    }
};
struct EpiResidMid : EpiResid<false> {
    static constexpr bool MIDK = true;
    const LAS float* rsl;
    __device__ __forceinline__ void mid(f32x4 (&acc)[2][2][4][2], const Unit& u, int ui, int wr, int wc, int fr, int fq) const {
#pragma unroll
        for (int ai = 0; ai < 2; ++ai)
#pragma unroll
            for (int m = 0; m < 4; ++m) { const float rs = rsl[ui * 256 + ai * HALF + wr * 64 + m * 16 + fr];
#pragma unroll
                for (int bj = 0; bj < 2; ++bj)
#pragma unroll
                    for (int n = 0; n < 2; ++n) acc[ai][bj][m][n] = acc[ai][bj][m][n] * rs; }
    }
};
struct EpiBf16 {
    static constexpr bool PERM = true, MIDK = false;
    bf16_t* O; int ldc; float scale0; const LAS float* rsl;
    __device__ __forceinline__ void operator()(const f32x4 (&acc)[2][2][4][2], const Unit& u, int ui, int wr, int wc, int fr, int fq) const {
        const int row0 = u.pm * BM + wr * 64 + fr, col0 = u.pn * BM + wc * 32 + 8 * fq;
#pragma unroll
        for (int ai = 0; ai < 2; ++ai)
#pragma unroll
            for (int m = 0; m < 4; ++m) { const int row = row0 + ai * HALF + m * 16; bf16_t* rowp = O + (size_t)row * ldc + col0;
                const float scale = scale0 * rsl[ui * 256 + (row & 255)];
#pragma unroll
                for (int bj = 0; bj < 2; ++bj) { const f32x4 v0 = acc[ai][bj][m][0] * scale, v1 = acc[ai][bj][m][1] * scale;
                    u32x4 w; w.x = cvt_pk_bf16(v0[0], v0[1]); w.y = cvt_pk_bf16(v0[2], v0[3]); w.z = cvt_pk_bf16(v1[0], v1[1]); w.w = cvt_pk_bf16(v1[2], v1[3]);
                    *(u32x4*)(rowp + bj * HALF) = w; } }
    }
};
struct EpiKV {
    static constexpr bool PERM = true, MIDK = false;
    bf16_t* KB; bf16_t* VT;
    __device__ __forceinline__ void operator()(const f32x4 (&acc)[2][2][4][2], const Unit& u, int ui, int wr, int wc, int fr, int fq) const {
        const int row0 = u.pm * BM + wr * 64 + fr, col0 = u.pn * BM + wc * 32 + 8 * fq;
#pragma unroll
        for (int ai = 0; ai < 2; ++ai)
#pragma unroll
            for (int m = 0; m < 4; ++m) { const int row = row0 + ai * HALF + m * 16;
#pragma unroll
                for (int bj = 0; bj < 2; ++bj) { const int col = col0 + bj * HALF;
                    if (col < 2048) { const f32x4 v0 = acc[ai][bj][m][0], v1 = acc[ai][bj][m][1];
                        u32x4 w; w.x = cvt_pk_bf16(v0[0], v0[1]); w.y = cvt_pk_bf16(v0[2], v0[3]); w.z = cvt_pk_bf16(v1[0], v1[1]); w.w = cvt_pk_bf16(v1[2], v1[3]);
                        *(u32x4*)(KB + (size_t)row * 2048 + col) = w;
                    } else {
#pragma unroll
                        for (int n = 0; n < 2; ++n)
#pragma unroll
                            for (int j = 0; j < 4; ++j) VT[(size_t)(col - 2048 + n * 4 + j) * 256 + row] = (bf16_t)(cvt_pk_bf16(acc[ai][bj][m][n][j], 0.f) & 0xffffu);
                    } } }
    }
};
struct EpiWin {
    static constexpr bool PERM = true, MIDK = false;
    bf16_t* P; float* dt; float* vpart; const LAS float* rsl; bf16_t* halo;
    __device__ __forceinline__ void operator()(const f32x4 (&acc)[2][2][4][2], const Unit& u, int ui, int wr, int wc, int fr, int fq) const {
        const int pn = u.pn;
        const int row0 = u.pm * BM + wr * 64 + fr;
        if (pn == 40) {
            if (wc == 0) {
#pragma unroll
                for (int ai = 0; ai < 2; ++ai)
#pragma unroll
                    for (int m = 0; m < 4; ++m) { const int row = row0 + ai * HALF + m * 16; float* rp = dt + (size_t)row * 32 + 8 * fq; const float rs = rsl[ui * 256 + (row & 255)];
                        *(f32x4*)rp = acc[ai][0][m][0] * rs; *(f32x4*)(rp + 4) = acc[ai][0][m][1] * rs; }
            }
            return;
        }
        const int mode = pn < 8 ? 0 : (pn < 16 ? 1 : (pn < 24 ? 2 : 3));
        const int col0 = pn * BM + wc * 32 + 8 * fq;
#pragma unroll
        for (int ai = 0; ai < 2; ++ai)
#pragma unroll
            for (int m = 0; m < 4; ++m) { const int row = row0 + ai * HALF + m * 16; bf16_t* rowp = P + (size_t)row * PW + col0; float ss = 0.f; const float rs = rsl[ui * 256 + (row & 255)];
#pragma unroll
                for (int bj = 0; bj < 2; ++bj) { float v[8];
#pragma unroll
                    for (int n = 0; n < 2; ++n)
#pragma unroll
                        for (int j = 0; j < 4; ++j) { float x = acc[ai][bj][m][n][j] * rs;
                            if (mode == 0 || mode == 2) x = gelu_f(x); else if (mode == 1) x = silu_f(x);
                            v[n * 4 + j] = x; ss += x * x; }
                    u32x4 w; w.x = cvt_pk_bf16(v[0], v[1]); w.y = cvt_pk_bf16(v[2], v[3]); w.z = cvt_pk_bf16(v[4], v[5]); w.w = cvt_pk_bf16(v[6], v[7]);
                    *(u32x4*)(rowp + bj * HALF) = w;
                    if (mode == 3 && (row & 31) >= 29) *(u32x4*)(halo + ((size_t)(row >> 5) * 3 + (row & 31) - 29) * 4096 + (col0 + bj * HALF - PX0)) = w; }
                if (mode == 2) { ss += __shfl_xor(ss, 16); ss += __shfl_xor(ss, 32); if (fq == 0) vpart[(size_t)row * 32 + (pn - 16) * 4 + wc] = ss; }
            }
    }
};
struct EpiFinal {
    static constexpr bool PERM = false, MIDK = false;
    const bf16_t* base; float* out; int ldc; float alpha; const float* nw;
    float* slots;
    unsigned* cnt;
    LAS float* ex;
    __device__ __forceinline__ void operator()(f32x4 (&acc)[2][2][4][2], const Unit& u, int ui, int wr, int wc, int fr, int fq) const {
        const int col0 = u.pn * BM + wc * 32 + 4 * fq;
        int tid = threadIdx.x; asm volatile("" : "+v"(tid));
        LAS float* Pl = ex; LAS float* Sl = ex + 1024;
#pragma unroll
        for (int ai = 0; ai < 2; ++ai)
#pragma unroll
            for (int m = 0; m < 4; ++m) {
                const int rl = ai * HALF + wr * 64 + m * 16 + fr; const size_t off = (size_t)(u.pm * BM + rl) * ldc + col0; float ss = 0.f;
#pragma unroll
                for (int bj = 0; bj < 2; ++bj)
#pragma unroll
                    for (int n = 0; n < 2; ++n) { const u32x2 r = *(const u32x2*)(base + off + bj * HALF + n * 16); const f32x4 b = {bflo(r.x), bfhi(r.x), bflo(r.y), bfhi(r.y)}; const f32x4 o = b + acc[ai][bj][m][n] * alpha; acc[ai][bj][m][n] = o;
                        ss += (o[0] * o[0] + o[1] * o[1]) + (o[2] * o[2] + o[3] * o[3]); }
                ss += __shfl_xor(ss, 16); ss += __shfl_xor(ss, 32);
                if (fq == 0) Pl[rl * 4 + wc] = ss;
            }
        __syncthreads();
        if (tid < 256) { const float t = (Pl[tid * 4 + 0] + Pl[tid * 4 + 1]) + (Pl[tid * 4 + 2] + Pl[tid * 4 + 3]);
            __hip_atomic_store(slots + (size_t)(u.pm * BM + tid) * 8 + u.pn, t, __ATOMIC_RELAXED, __HIP_MEMORY_SCOPE_AGENT);
            asm volatile("s_waitcnt vmcnt(0)" ::: "memory");
            if ((tid & 63) == 0) __hip_atomic_fetch_add(cnt + 64 * u.pm, 1u, __ATOMIC_RELAXED, __HIP_MEMORY_SCOPE_AGENT); }
        if (tid < 64) { unsigned sp = 0;
            while (__hip_atomic_load(cnt + 64 * u.pm, __ATOMIC_RELAXED, __HIP_MEMORY_SCOPE_AGENT) < 32u) { __builtin_amdgcn_s_sleep(1); if (++sp > (1u << 22)) break; }
            __builtin_amdgcn_fence(__ATOMIC_ACQUIRE, "agent"); asm volatile("s_waitcnt vmcnt(0)" ::: "memory"); }
        __syncthreads();
        if (tid < 256) { const float* sp = slots + (size_t)(u.pm * BM + tid) * 8; float t = 0.f;
#pragma unroll
            for (int q = 0; q < 8; ++q) t += __hip_atomic_load(sp + q, __ATOMIC_RELAXED, __HIP_MEMORY_SCOPE_AGENT);
            Sl[tid] = rsqrtf(t * (1.0f / 2048.0f) + EPS); }
        __syncthreads();
#pragma unroll
        for (int ai = 0; ai < 2; ++ai)
#pragma unroll
            for (int m = 0; m < 4; ++m) { const int rl = ai * HALF + wr * 64 + m * 16 + fr; const size_t off = (size_t)(u.pm * BM + rl) * ldc + col0; const float rs = Sl[rl];
#pragma unroll
                for (int bj = 0; bj < 2; ++bj)
#pragma unroll
                    for (int n = 0; n < 2; ++n) { const f32x4 w = *(const f32x4*)(nw + col0 + bj * HALF + n * 16); __builtin_nontemporal_store(acc[ai][bj][m][n] * rs * w, (f32x4*)(out + off + bj * HALF + n * 16)); }
            }
    }
};
}

template <class Sched> __device__ __forceinline__ void prep_rstd(const Sched& S, const float* part, LAS float* rsl) {
    const int tid = threadIdx.x; pg8::Unit u;
    for (int i0 = 0; S.next(i0, u); i0 += 2) {
        const int i = i0 + (tid >> 8);
        if (S.next(i, u)) { const f32x4* pp = (const f32x4*)(part + (size_t)(u.pm * 256 + (tid & 255)) * 32); float sm = 0.f;
#pragma unroll
            for (int q = 0; q < 8; ++q) { const f32x4 t = pp[q]; sm += (t[0] + t[1]) + (t[2] + t[3]); }
            rsl[i * 256 + (tid & 255)] = rsqrtf(sm * (1.f / 2048.f) + EPS); }
    }
    __syncthreads();
}

struct Args { const float* in[26]; float* out; unsigned char* ws; };

__device__ __forceinline__ int maprow(int mode, int n0) {
    if (mode == 1) { return n0 < DFF ? (n0 / 128) * 256 + (n0 % 128) : ((n0 - DFF) / 128) * 256 + 128 + ((n0 - DFF) % 128); }
    if (mode == 2) { return (n0 >= 2048 && n0 < 4096) ? n0 + 2048 : ((n0 >= 4096 && n0 < 6144) ? n0 - 2048 : n0); }
    return n0;
}
__device__ __forceinline__ void tr_item(const float* W, int K, int N, bf16_t* WT, int mode, LAS float* scr, int item, int lane, const float* ks = nullptr) {
    const int nblk = N / 32, kb = item / nblk, nb = item % nblk, k0 = 64 * kb, n0 = 32 * nb;
    const int r0 = maprow(mode, n0);
    const int kd = (mode == 3) ? ((k0 + 2048) & 4095) : k0;
    f32x4 ld[8];
#pragma unroll
    for (int i = 0; i < 8; ++i) ld[i] = __builtin_nontemporal_load((const f32x4*)(W + (size_t)(k0 + 8 * i + (lane >> 3)) * N + n0 + (lane & 7) * 4));
    if (ks) {
#pragma unroll
        for (int i = 0; i < 8; ++i) ld[i] = ld[i] * ks[k0 + 8 * i + (lane >> 3)]; }
#pragma unroll
    for (int i = 0; i < 8; ++i) { LAS float* d = scr + (8 * i + (lane >> 3)) * 33 + (lane & 7) * 4; d[0] = ld[i][0]; d[1] = ld[i][1]; d[2] = ld[i][2]; d[3] = ld[i][3]; }
    asm volatile("s_waitcnt lgkmcnt(0)" ::: "memory");
    const int c = lane & 7;
#pragma unroll
    for (int j = 0; j < 4; ++j) { const int n = (lane >> 3) + 8 * j; const LAS float* s = scr + (8 * c) * 33 + n;
        u32x4 o; o.x = cvt_pk_bf16(s[0 * 33], s[1 * 33]); o.y = cvt_pk_bf16(s[2 * 33], s[3 * 33]); o.z = cvt_pk_bf16(s[4 * 33], s[5 * 33]); o.w = cvt_pk_bf16(s[6 * 33], s[7 * 33]);
        *(u32x4*)(WT + (size_t)(r0 + n) * K + kd + 8 * c) = o; }
    asm volatile("s_waitcnt lgkmcnt(0)" ::: "memory");
}
__device__ __forceinline__ void norm_row_bf16(const float* xrow, const float* w, bf16_t* orow, int lane) {
    const f32x4* xr = (const f32x4*)xrow + lane; const f32x4* wr = (const f32x4*)w + lane;
    f32x4 v[8]; float s = 0.f;
#pragma unroll
    for (int j = 0; j < 8; ++j) { v[j] = xr[64 * j]; s += (v[j].x * v[j].x + v[j].y * v[j].y) + (v[j].z * v[j].z + v[j].w * v[j].w); }
    const float rstd = rsqrtf(wave_sum(s) * (1.f / 2048.f) + EPS);
    u32x2* o8 = (u32x2*)orow + lane;
#pragma unroll
    for (int j = 0; j < 8; ++j) { const f32x4 ww = wr[64 * j]; u32x2 o; o.x = cvt_pk_bf16(v[j].x * rstd * ww.x, v[j].y * rstd * ww.y); o.y = cvt_pk_bf16(v[j].z * rstd * ww.z, v[j].w * rstd * ww.w); o8[64 * j] = o; }
}
__device__ __forceinline__ void wrow_bf16(const float* xrow, const float* w, bf16_t* orow, float* part, int lane) {
    const f32x4* xr = (const f32x4*)xrow + lane; const f32x4* wr = (const f32x4*)w + lane;
    f32x4 v[8]; float s = 0.f;
#pragma unroll
    for (int j = 0; j < 8; ++j) { v[j] = xr[64 * j]; s += (v[j].x * v[j].x + v[j].y * v[j].y) + (v[j].z * v[j].z + v[j].w * v[j].w); }
    s = wave_sum(s);
    if (lane < 32) part[lane] = lane == 0 ? s : 0.f;
    u32x2* o8 = (u32x2*)orow + lane;
#pragma unroll
    for (int j = 0; j < 8; ++j) { const f32x4 ww = wr[64 * j]; u32x2 o; o.x = cvt_pk_bf16(v[j].x * ww.x, v[j].y * ww.y); o.y = cvt_pk_bf16(v[j].z * ww.z, v[j].w * ww.w); o8[64 * j] = o; }
}
__device__ __forceinline__ void norm_row_from_bf16(const bf16_t* xrow, const float* w, float* orow, int lane) {
    const u32x2* xr = (const u32x2*)xrow + lane; const f32x4* wr = (const f32x4*)w + lane;
    f32x4 v[8]; float s = 0.f;
#pragma unroll
    for (int j = 0; j < 8; ++j) { const u32x2 r = xr[64 * j]; v[j] = (f32x4){bflo(r.x), bfhi(r.x), bflo(r.y), bfhi(r.y)}; s += (v[j].x * v[j].x + v[j].y * v[j].y) + (v[j].z * v[j].z + v[j].w * v[j].w); }
    const float rstd = rsqrtf(wave_sum(s) * (1.f / 2048.f) + EPS);
    f32x4* o = (f32x4*)orow + lane;
#pragma unroll
    for (int j = 0; j < 8; ++j) { const f32x4 ww = wr[64 * j]; o[64 * j] = v[j] * rstd * ww; }
}
__device__ __forceinline__ void norm_row_f32(const float* xrow, const float* w, float* orow, int lane, float addc) {
    const f32x4* xr = (const f32x4*)xrow + lane; const f32x4* wr = (const f32x4*)w + lane;
    f32x4 v[8]; float s = 0.f;
#pragma unroll
    for (int j = 0; j < 8; ++j) { v[j] = xr[64 * j]; s += (v[j].x * v[j].x + v[j].y * v[j].y) + (v[j].z * v[j].z + v[j].w * v[j].w); }
    const float rstd = rsqrtf(wave_sum(s) * (1.f / 2048.f) + EPS);
    f32x4* o = (f32x4*)orow + lane;
#pragma unroll
    for (int j = 0; j < 8; ++j) { const f32x4 ww = wr[64 * j]; o[64 * j] = v[j] * rstd * ww + addc; }
}

constexpr int LP = 272;
__device__ __forceinline__ void conv8(const bf16_t* P, int tok, int col, int ch, const float* cw, const float* cb, float (&o)[8]) {
    const f32x4 b0 = *(const f32x4*)(cb + ch), b1 = *(const f32x4*)(cb + ch + 4);
    float a[8] = {b0[0], b0[1], b0[2], b0[3], b1[0], b1[1], b1[2], b1[3]};
#pragma unroll
    for (int k = 0; k < 4; ++k) { const int r = tok - 3 + k;
        if (r >= 0) { const u32x4 raw = *(const u32x4*)(P + (size_t)r * PW + col);
            const f32x4 w0 = *(const f32x4*)(cw + k * 4096 + ch), w1 = *(const f32x4*)(cw + k * 4096 + ch + 4);
            a[0] += bflo(raw.x) * w0[0]; a[1] += bfhi(raw.x) * w0[1]; a[2] += bflo(raw.y) * w0[2]; a[3] += bfhi(raw.y) * w0[3];
            a[4] += bflo(raw.z) * w1[0]; a[5] += bfhi(raw.z) * w1[1]; a[6] += bflo(raw.w) * w1[2]; a[7] += bfhi(raw.w) * w1[3]; } }
#pragma unroll
    for (int i = 0; i < 8; ++i) o[i] = silu_f(a[i]);
}
__device__ __forceinline__ float softplus_f(float x) { return x > 20.f ? x : log1pf(expf(x)); }
__device__ __forceinline__ void dt_cum(const float* dtraw, int tok0, int h, const float* dt_bias, const float* a_log, LAS float* dtv, LAS float* cum, int lane) {
    const float bias = dt_bias[h], a = -expf(a_log[h]);
    const int l0 = 2 * lane;
    const float d0 = softplus_f(dtraw[(size_t)(tok0 + l0) * 32 + h] + bias), d1 = softplus_f(dtraw[(size_t)(tok0 + l0 + 1) * 32 + h] + bias);
    const float s0 = d0 * a, s1 = s0 + d1 * a;
    float incl = s1;
#pragma unroll
    for (int o = 1; o < 64; o <<= 1) { const float t = __shfl_up(incl, o); if (lane >= o) incl += t; }
    const float excl = incl - s1;
    cum[l0] = excl + s0; cum[l0 + 1] = incl; dtv[l0] = d0; dtv[l0 + 1] = d1;
}

#define XB_TMO      128
#define XB_XCNT(j)  (256  + 64 * (j))
#define XB_XSUB(j)  (1280 + 64 * (j))
#define XB_XGEN(j)  (2304 + 64 * (j))
#define XB_TOP      3328
#define XB_TOPGEN   3392
#define XCD_BAR_WORDS 3456
#define XB_SPIN_CAP (1u << 22)
__device__ __forceinline__ unsigned xb_ld(unsigned* p)              { return __hip_atomic_load(p, __ATOMIC_RELAXED, __HIP_MEMORY_SCOPE_AGENT); }
__device__ __forceinline__ unsigned xb_add(unsigned* p, unsigned v) { return __hip_atomic_fetch_add(p, v, __ATOMIC_RELAXED, __HIP_MEMORY_SCOPE_AGENT); }
__device__ __forceinline__ unsigned xb_xcc_id() { return (unsigned)__builtin_amdgcn_s_getreg((3 << 11) | 20) & 0xFu; }
#define XB_SPIN(cond, bar) do { unsigned _sp = 0; while (cond) { __builtin_amdgcn_s_sleep(1); \
    if ((++_sp & 255u) == 0u) { if (xb_ld(&(bar)[XB_TMO])) break; if (_sp > XB_SPIN_CAP) { atomicAdd(&(bar)[XB_TMO], 1u); break; } } } } while (0)
struct XcdBarrier { unsigned* bar; unsigned x; volatile LAS unsigned* st; };
__device__ __forceinline__ XcdBarrier xcd_barrier_post(unsigned* bar, volatile LAS unsigned* st) {
    XcdBarrier b; b.bar = bar; b.x = xb_xcc_id(); b.st = st;
    if (threadIdx.x == 0) (void)xb_add(&bar[XB_XCNT(b.x)], 1u);
    return b;
}
__device__ __forceinline__ void xcd_barrier_complete(unsigned* bar, unsigned x, unsigned& nloc, unsigned& nx) {
    const unsigned G = gridDim.x * gridDim.y * gridDim.z;
    unsigned sum, cnt, mine, sp = 0u;
    for (;;) {
        sum = 0u; cnt = 0u; mine = 0u;
#pragma unroll
        for (unsigned j = 0; j < 16; ++j) { const unsigned c = xb_ld(&bar[XB_XCNT(j)]); sum += c; cnt += (c > 0u) ? 1u : 0u; mine = (j == x) ? c : mine; }
        if (sum == G) break;
        __builtin_amdgcn_s_sleep(1);
        if ((++sp & 255u) == 0u) { if (xb_ld(&bar[XB_TMO])) break; if (sp > XB_SPIN_CAP) { atomicAdd(&bar[XB_TMO], 1u); break; } }
    }
    nloc = mine > 0u ? mine : 1u; nx = cnt > 0u ? cnt : 1u;
}
__device__ __forceinline__ void xcd_barrier(const XcdBarrier& b) {
    asm volatile("s_waitcnt vmcnt(0)" ::: "memory");
    __syncthreads();
    if (threadIdx.x == 0) {
        unsigned* bar = b.bar;
        __builtin_amdgcn_s_waitcnt(0);
        unsigned nloc = b.st[0], nx = b.st[1];
        if (nloc == 0u) { xcd_barrier_complete(bar, b.x, nloc, nx); b.st[0] = nloc; b.st[1] = nx; }
        const unsigned old = xb_add(&bar[XB_XSUB(b.x)], 1u);
        const unsigned gen = old / nloc;
        if (old + 1u == (gen + 1u) * nloc) {
            __builtin_amdgcn_fence(__ATOMIC_RELEASE, "agent");
            asm volatile("s_waitcnt vmcnt(0)" ::: "memory");
            const unsigned og = xb_add(&bar[XB_TOP], 1u);
            const unsigned tg = og / nx;
            if (og + 1u == (tg + 1u) * nx) xb_add(&bar[XB_TOPGEN], 1u);
            else XB_SPIN(xb_ld(&bar[XB_TOPGEN]) == tg, bar);
            __builtin_amdgcn_fence(__ATOMIC_ACQUIRE, "agent");
            xb_add(&bar[XB_XGEN(b.x)], 1u);
            asm volatile("s_waitcnt vmcnt(0)" ::: "memory");
        } else {
            XB_SPIN(xb_ld(&bar[XB_XGEN(b.x)]) == gen, bar);
            __builtin_amdgcn_fence(__ATOMIC_ACQUIRE, "agent");
            asm volatile("s_waitcnt vmcnt(0)" ::: "memory");
        }
    }
    __syncthreads();
}

#define CG_SYNC() do { asm volatile("s_waitcnt vmcnt(0) lgkmcnt(0)" ::: "memory"); __syncthreads(); grid.sync(); __builtin_amdgcn_fence(__ATOMIC_ACQUIRE, "agent"); asm volatile("s_waitcnt vmcnt(0)" ::: "memory"); __syncthreads(); } while (0)
#define GRID_SYNC() for (int rs_ = 0; rs_ < REP_SYNC; ++rs_) xcd_barrier(xbar)
__device__ __forceinline__ void dt_cum_r(float r0, float r1, int h, const float* dt_bias, const float* a_log, LAS float* dtv, LAS float* cum, int lane) {
    const float bias = dt_bias[h], a = -expf(a_log[h]);
    const int l0 = 2 * lane;
    const float d0 = softplus_f(r0 + bias), d1 = softplus_f(r1 + bias);
    const float s0 = d0 * a, s1 = s0 + d1 * a;
    float incl = s1;
#pragma unroll
    for (int o = 1; o < 64; o <<= 1) { const float t = __shfl_up(incl, o); if (lane >= o) incl += t; }
    const float excl = incl - s1;
    cum[l0] = excl + s0; cum[l0 + 1] = incl; dtv[l0] = d0; dtv[l0 + 1] = d1;
}
#define SCATTER8(dst, raw) do { \
    *(LAS unsigned short*)((dst) + 0 * LP) = (unsigned short)((raw).x & 0xffffu); *(LAS unsigned short*)((dst) + 1 * LP) = (unsigned short)((raw).x >> 16); \
    *(LAS unsigned short*)((dst) + 2 * LP) = (unsigned short)((raw).y & 0xffffu); *(LAS unsigned short*)((dst) + 3 * LP) = (unsigned short)((raw).y >> 16); \
    *(LAS unsigned short*)((dst) + 4 * LP) = (unsigned short)((raw).z & 0xffffu); *(LAS unsigned short*)((dst) + 5 * LP) = (unsigned short)((raw).z >> 16); \
    *(LAS unsigned short*)((dst) + 6 * LP) = (unsigned short)((raw).w & 0xffffu); *(LAS unsigned short*)((dst) + 7 * LP) = (unsigned short)((raw).w >> 16); } while (0)
#define MFMA16(a, b, c) __builtin_amdgcn_mfma_f32_16x16x32_bf16((a), (b), (c), 0, 0, 0)

__global__ void __launch_bounds__(512, 2) mega_fwd(Args args) {
    extern __shared__ __attribute__((aligned(16))) unsigned char lds_raw[];
    LAS unsigned char* lds = (LAS unsigned char*)lds_raw;
    cg::grid_group grid = cg::this_grid();
    const int G = gridDim.x, bid = blockIdx.x;
#define PHASE_IDS const CAS gfptr* inp = (const CAS gfptr*)__builtin_amdgcn_kernarg_segment_ptr(); asm volatile("" : "+s"(inp)); (void)inp; int tid = threadIdx.x; asm volatile("" : "+v"(tid)); const int lane = tid & 63, wave = __builtin_amdgcn_readfirstlane(tid >> 6); \
    const int gw = bid * 8 + wave, NGW = G * 8; const int fr = lane & 15, fq = lane >> 4; (void)gw; (void)NGW; (void)fr; (void)fq; (void)lane;
    unsigned char* ws = args.ws;
    volatile LAS unsigned* MISC = (volatile LAS unsigned*)(lds + LDS_BYTES - 128);
    if (threadIdx.x < 32) MISC[threadIdx.x] = 0u;
    __syncthreads();
    const XcdBarrier xbar = xcd_barrier_post((unsigned*)ws, MISC + 8);
    unsigned long long pa0 = 0, pa1 = 0, pb0 = 0, pb1 = 0;
#define STAMP(k) do { if (PROBE_A >= 0) { const unsigned long long t_ = __builtin_amdgcn_s_memrealtime(); if ((k) == PROBE_A) pa0 = t_; if ((k) == PROBE_A + 1) pa1 = t_; if ((k) == PROBE_B) pb0 = t_; if ((k) == PROBE_B + 1) pb1 = t_; } } while (0)
    STAMP(0);
    bf16_t* HB = (bf16_t*)(ws + WS_WGU1);
    bf16_t* WGU1 = (bf16_t*)(ws + WS_WGU1); bf16_t* WD1 = (bf16_t*)(ws + WS_WD1); bf16_t* WIN = (bf16_t*)(ws + WS_WIN);
    bf16_t* WOUTA = (bf16_t*)(ws + WS_WOUTA); bf16_t* WOUTM = (bf16_t*)(ws + WS_WOUTM); bf16_t* WQ = (bf16_t*)(ws + WS_WQ);
    bf16_t* WKV = (bf16_t*)(ws + WS_WKV); bf16_t* WO = (bf16_t*)(ws + WS_WO); bf16_t* WGU2 = (bf16_t*)(ws + WS_WGU2); bf16_t* WD2 = (bf16_t*)(ws + WS_WD2);
    bf16_t* XN = (bf16_t*)(ws + WS_XN); bf16_t* P = (bf16_t*)(ws + WS_P); bf16_t* ACT = (bf16_t*)(ws + WS_ACT); bf16_t* ACT2 = (bf16_t*)(ws + WS_ACT2);
    bf16_t* QB = (bf16_t*)(ws + WS_Q); bf16_t* OB = (bf16_t*)(ws + WS_O);
    float* ST = (float*)(ws + WS_ST); float* DT = (float*)(ws + WS_DT); float* VPART = (float*)(ws + WS_VPART); float* YPART = (float*)(ws + WS_YPART);
    float* NPA = (float*)(ws + WS_NPA); float* NPB = (float*)(ws + WS_NPB); float* NPC = (float*)(ws + WS_NPC); float* NPD = (float*)(ws + WS_NPD);
    bf16_t* HALO = (bf16_t*)(ws + WS_HALO);
    float* CDEC = (float*)(ws + WS_CDEC); bf16_t* KB = (bf16_t*)(ws + WS_KB); bf16_t* VT = (bf16_t*)(ws + WS_VT); bf16_t* MEMN = (bf16_t*)(ws + WS_MEMN);

    constexpr int I_GU = 32 * 352, I_DN = 88 * 64, I_WIN = 32 * 321, I_SQ = 32 * 64, I_KV = 32 * 128;
    constexpr int CV_P0_END = I_GU + I_KV, CV_P1_END = I_GU + I_KV + I_WIN + I_DN, CV_END = 2 * I_GU + 2 * I_DN + I_WIN + 4 * I_SQ + I_KV, CV_P4_END = CV_END - I_DN;
#define CONVERT_RANGE(lo, hi, rank, nwork) do { LAS float* scr_ = (LAS float*)(lds + wave * 16384); \
        for (int it_ = (lo) + (rank) * 8 + wave; it_ < (hi); it_ += (nwork) * 8) { int r_ = it_; \
            if (r_ < I_GU) { tr_item(((const float*)inp[3]), DM, 2 * DFF, WGU1, 1, scr_, r_, lane); continue; } r_ -= I_GU; \
            if (r_ < I_KV) { tr_item(((const float*)inp[20]), DM, 2 * DM, WKV, 0, scr_, r_, lane); continue; } r_ -= I_KV; \
            if (r_ < I_WIN) { tr_item(((const float*)inp[6]), DM, 10272, WIN, 2, scr_, r_, lane, ((const float*)inp[5])); continue; } r_ -= I_WIN; \
            if (r_ < I_DN) { tr_item(((const float*)inp[4]), DFF, DM, WD1, 0, scr_, r_, lane); continue; } r_ -= I_DN; \
            if (r_ < 2 * I_SQ) { tr_item(((const float*)inp[16]), 2 * DM, DM, WOUTA, 3, scr_, r_, lane); continue; } r_ -= 2 * I_SQ; \
            if (r_ < I_SQ) { tr_item(((const float*)inp[19]), DM, DM, WQ, 0, scr_, r_, lane, ((const float*)inp[17])); continue; } r_ -= I_SQ; \
            if (r_ < I_SQ) { tr_item(((const float*)inp[21]), DM, DM, WO, 0, scr_, r_, lane); continue; } r_ -= I_SQ; \
            if (r_ < I_GU) { tr_item(((const float*)inp[23]), DM, 2 * DFF, WGU2, 1, scr_, r_, lane, ((const float*)inp[22])); continue; } r_ -= I_GU; \
            tr_item(((const float*)inp[24]), DFF, DM, WD2, 0, scr_, r_, lane); } } while (0)

    { PHASE_IDS
        CONVERT_RANGE(0, CV_P0_END, bid, G);
        for (int m = gw; m < SEQ + MEML; m += NGW) {
            if (m < SEQ) wrow_bf16(((const float*)inp[0]) + (size_t)m * DM, ((const float*)inp[2]), XN + (size_t)m * DM, NPD + (size_t)m * 32, lane);
            else norm_row_bf16(((const float*)inp[1]) + (size_t)(m - SEQ) * DM, ((const float*)inp[18]), MEMN + (size_t)(m - SEQ) * DM, lane);
        }
    }
    if (args.out == nullptr) CG_SYNC();
    GRID_SYNC(); STAMP(1);

    {
        pg8::Gemm g{XN, WGU1, SEQ, 2 * DFF, DM, DM}; pg8::StaticOrder S; S.init(SEQ, 2 * DFF, G, bid);
        LAS float* rsl = (LAS float*)(lds + 131072); prep_rstd(S, NPD, rsl);
        pg8::EpiSwiGLU E{ACT, DFF, rsl};
        pg8::gemm_phase<pg8::EpiSwiGLU, pg8::StaticOrder, true>(lds, g, S, E);
        pg8::Gemm g2{MEMN, WKV, MEML, 2 * DM, DM, DM}; pg8::StaticOrder S2; S2.init(MEML, 2 * DM, G, (bid + G - (G / 2)) % G);
        pg8::EpiKV E2{KB, VT};
        pg8::gemm_phase<pg8::EpiKV, pg8::StaticOrder, true>(lds, g2, S2, E2);
        { PHASE_IDS
            const int ntile = 32 * 44, full = (ntile + G - 1) / G, istart = ntile - (full - 1) * G + 16; const bool all = istart >= G;
            __syncthreads();
            if (all || bid >= istart) CONVERT_RANGE(CV_P0_END, CV_P1_END, (all ? bid : bid - istart), (all ? G : G - istart)); }
    }
    GRID_SYNC(); STAMP(2);

    {
        pg8::Gemm g{ACT, WD1, SEQ, DM, DFF, DFF}; pg8::StaticOrder S; S.init(SEQ, DM, G, bid); S.rep = REPG_P2;
        const CAS gfptr* inp = (const CAS gfptr*)__builtin_amdgcn_kernarg_segment_ptr();
        pg8::EpiResid<true> E{((const float*)inp[0]), HB, DM, 0.5f, nullptr, nullptr, nullptr, NPA};
        pg8::gemm_phase<pg8::EpiResid<true>, pg8::StaticOrder, true>(lds, g, S, E);
    }
    GRID_SYNC(); STAMP(3);


    {
        pg8::Gemm g{HB, WIN, SEQ, 41 * 256, DM, DM}; pg8::StaticOrder S; S.init(SEQ, 41 * 256, G, bid); S.rep = REPG_P4;
        LAS float* rsl = (LAS float*)(lds + 131072); prep_rstd(S, NPA, rsl);
        pg8::EpiWin E{P, DT, VPART, rsl, HALO};
        pg8::gemm_phase<pg8::EpiWin, pg8::StaticOrder, true>(lds, g, S, E);
        { PHASE_IDS
            const int ntile = 32 * 41, full = (ntile + G - 1) / G, istart = ntile - (full - 1) * G; const bool all = istart >= G;
            __syncthreads();
            if (all || bid >= istart) CONVERT_RANGE(CV_P1_END, CV_P4_END, (all ? bid : bid - istart), (all ? G : G - istart)); }
    }
    GRID_SYNC(); STAMP(5);

    { PHASE_IDS
        const float* cw = ((const float*)inp[10]); const float* cb = ((const float*)inp[11]);
        const int ch = tid * 8;
        for (int rb = bid; rb < SEQ / 32; rb += G) {
            f32x4 w0[4], w1[4];
#pragma unroll
            for (int k = 0; k < 4; ++k) { w0[k] = *(const f32x4*)(cw + k * 4096 + ch); w1[k] = *(const f32x4*)(cw + k * 4096 + ch + 4); }
            const f32x4 b0 = *(const f32x4*)(cb + ch), b1 = *(const f32x4*)(cb + ch + 4);
            f32x4 xa[3], xb[3];
#pragma unroll
            for (int k = 0; k < 3; ++k) { u32x4 raw = {0u, 0u, 0u, 0u}; if (rb > 0) raw = *(const u32x4*)(HALO + ((size_t)(rb - 1) * 3 + k) * 4096 + ch);
                xa[k] = (f32x4){bflo(raw.x), bfhi(raw.x), bflo(raw.y), bfhi(raw.y)}; xb[k] = (f32x4){bflo(raw.z), bfhi(raw.z), bflo(raw.w), bfhi(raw.w)}; }
            bf16_t* pp = P + (size_t)(rb * 32) * PW + PX0 + ch;
#pragma unroll 8
            for (int r = 0; r < 32; ++r) { const u32x4 raw = *(const u32x4*)(pp + (size_t)r * PW);
                const f32x4 ca = {bflo(raw.x), bfhi(raw.x), bflo(raw.y), bfhi(raw.y)}, cbv = {bflo(raw.z), bfhi(raw.z), bflo(raw.w), bfhi(raw.w)};
                const f32x4 ya = b0 + w0[0] * xa[0] + w0[1] * xa[1] + w0[2] * xa[2] + w0[3] * ca, yb = b1 + w1[0] * xb[0] + w1[1] * xb[1] + w1[2] * xb[2] + w1[3] * cbv;
                u32x4 o; o.x = cvt_pk_bf16(silu_f(ya[0]), silu_f(ya[1])); o.y = cvt_pk_bf16(silu_f(ya[2]), silu_f(ya[3])); o.z = cvt_pk_bf16(silu_f(yb[0]), silu_f(yb[1])); o.w = cvt_pk_bf16(silu_f(yb[2]), silu_f(yb[3]));
                *(u32x4*)(pp + (size_t)r * PW) = o;
                xa[0] = xa[1]; xa[1] = xa[2]; xa[2] = ca; xb[0] = xb[1]; xb[1] = xb[2]; xb[2] = cbv; }
        }
    }
    { PHASE_IDS
        constexpr int GV0_OFF = 0, GV1_OFF = 128 * LP, AM_OFF = 2 * 128 * LP, RS_OFF = 3 * 128 * LP;
        LAS float* rs = (LAS float*)(lds + RS_OFF);
        const float* w_s = ((const float*)inp[8]); const float* b_s = ((const float*)inp[9]); const float* vnw = ((const float*)inp[7]);
        for (int unit = bid; unit < 64 * 4; unit += G) {
            const int c = unit >> 2, g = unit & 3, tok0 = c * 128;
            u32x4 rg[4];
#define GV_LOAD(DQ) do { _Pragma("unroll") for (int k = 0; k < 4; ++k) rg[k] = *(const u32x4*)(P + (size_t)(tok0 + (tid >> 4) + 32 * k) * PW + PV0 + g * 512 + (DQ) * 128 + (tid & 15) * 8); } while (0)
#define GV_SCATTER(BUF) do { _Pragma("unroll") for (int k = 0; k < 4; ++k) { LAS unsigned char* dst = lds + (BUF) + ((tid & 15) * 8) * LP + ((tid >> 4) + 32 * k) * 2; SCATTER8(dst, rg[k]); } } while (0)
            GV_LOAD(0);
            __syncthreads();
            if (tid < 128) { const f32x4* pp = (const f32x4*)(VPART + (size_t)(tok0 + tid) * 32); float sm = 0.f;
#pragma unroll
                for (int q = 0; q < 8; ++q) { const f32x4 t = pp[q]; sm += (t[0] + t[1]) + (t[2] + t[3]); }
                rs[tid] = rsqrtf(sm * (1.f / 2048.f) + EPS); }
            __syncthreads();
#pragma unroll
            for (int k = 0; k < 4; ++k) { const int t = (tid >> 4) + 32 * k, s8 = (tid & 15) * 8;
                const f32x4 w0 = *(const f32x4*)(w_s + ((size_t)g * 128 + t) * 128 + s8), w1 = *(const f32x4*)(w_s + ((size_t)g * 128 + t) * 128 + s8 + 4);
                float v[8] = {w0[0], w0[1], w0[2], w0[3], w1[0], w1[1], w1[2], w1[3]};
#pragma unroll
                for (int q = 0; q < 8; ++q) v[q] = (s8 + q <= t) ? v[q] * rs[s8 + q] : 0.f;
                *(LAS bf16x8*)(lds + AM_OFF + t * LP + s8 * 2) = pack8(v); }
            GV_SCATTER(GV0_OFF);
            GV_LOAD(1);
            __syncthreads();
#pragma unroll
            for (int dq = 0; dq < 4; ++dq) {
                const int gvb = (dq & 1) ? GV1_OFF : GV0_OFF, ch0 = g * 512 + dq * 128;
                u32x2 uu[8];
#pragma unroll
                for (int tt = 0; tt < 8; ++tt) uu[tt] = *(const u32x2*)(P + (size_t)(tok0 + tt * 16 + fr) * PW + PU0 + ch0 + 16 * wave + fq * 4);
                bf16x8 afr[4];
#pragma unroll
                for (int kk = 0; kk < 4; ++kk) afr[kk] = *(LAS bf16x8*)(lds + gvb + (16 * wave + fr) * LP + (kk * 32 + fq * 8) * 2);
                const f32x4 wv = *(const f32x4*)(vnw + ch0 + 16 * wave + fq * 4);
#pragma unroll
                for (int tt = 0; tt < 8; ++tt) { f32x4 acc = {0.f, 0.f, 0.f, 0.f};
#pragma unroll
                    for (int kk = 0; kk < 4; ++kk) { const bf16x8 bq = *(LAS bf16x8*)(lds + AM_OFF + (tt * 16 + fr) * LP + (kk * 32 + fq * 8) * 2); acc = MFMA16(afr[kk], bq, acc); }
                    const int t = tt * 16 + fr; const float bb = b_s[g * 128 + t];
                    bf16_t* up = P + (size_t)(tok0 + t) * PW + PU0 + ch0 + 16 * wave + fq * 4;
                    u32x2 o; o.x = cvt_pk_bf16(bflo(uu[tt].x) * (acc[0] * wv[0] + bb), bfhi(uu[tt].x) * (acc[1] * wv[1] + bb)); o.y = cvt_pk_bf16(bflo(uu[tt].y) * (acc[2] * wv[2] + bb), bfhi(uu[tt].y) * (acc[3] * wv[3] + bb));
                    *(u32x2*)up = o; }
                if (dq < 3) { GV_SCATTER((dq & 1) ? GV0_OFF : GV1_OFF); if (dq < 2) GV_LOAD(dq + 2); __syncthreads(); }
            }
#undef GV_LOAD
#undef GV_SCATTER
        }
    }
    GRID_SYNC(); STAMP(4);

    { PHASE_IDS
        constexpr int XT_OFF = 0, BP_OFF = 64 * LP, SC_OFF = BP_OFF + 128 * LP;
        LAS float* dtv = (LAS float*)(lds + SC_OFF); LAS float* cum = dtv + 128;
        const float* dtb = ((const float*)inp[12]); const float* alog = ((const float*)inp[13]);
        constexpr int NU = REPU_P5A * 64 * NHEAD;
        u32x4 rx[2], rb[4]; float rd0 = 0.f, rd1 = 0.f;
#define P5A_LOAD(UU) do { const int un_ = (UU) % (64 * NHEAD); const int h_ = un_ & 31, g_ = h_ >> 2, t_ = (un_ >> 5) * 128; \
            _Pragma("unroll") for (int k = 0; k < 2; ++k) rx[k] = *(const u32x4*)(P + (size_t)(t_ + (tid >> 3) + 64 * k) * PW + PX0 + h_ * 64 + (tid & 7) * 8); \
            _Pragma("unroll") for (int k = 0; k < 4; ++k) rb[k] = *(const u32x4*)(P + (size_t)(t_ + (tid >> 4) + 32 * k) * PW + PX0 + 2048 + g_ * 128 + (tid & 15) * 8); \
            rd0 = DT[(size_t)(t_ + 2 * lane) * 32 + h_]; rd1 = DT[(size_t)(t_ + 2 * lane + 1) * 32 + h_]; } while (0)
        int uu = bid;
        if (uu < NU) P5A_LOAD(uu);
        for (; uu < NU; uu += G) { const int unit = uu % (64 * NHEAD);
            const int c = unit >> 5, h = unit & 31;
            __syncthreads();
            if (wave == 0) dt_cum_r(rd0, rd1, h, dtb, alog, dtv, cum, lane);
#pragma unroll
            for (int k = 0; k < 2; ++k) { LAS unsigned char* dst = lds + XT_OFF + ((tid & 7) * 8) * LP + ((tid >> 3) + 64 * k) * 2; SCATTER8(dst, rx[k]); }
#pragma unroll
            for (int k = 0; k < 4; ++k) *(LAS u32x4*)(lds + BP_OFF + ((tid >> 4) + 32 * k) * LP + (tid & 15) * 16) = rb[k];
            if (uu + G < NU) P5A_LOAD(uu + G);
            __syncthreads();
            const float cl = cum[127];
            if (tid == 0) CDEC[c * 32 + h] = expf(cl);
            bf16x8 bfr[4];
#pragma unroll
            for (int kk = 0; kk < 4; ++kk) { bf16x8 t;
#pragma unroll
                for (int j = 0; j < 8; ++j) t[j] = (short)*(LAS unsigned short*)(lds + BP_OFF + (kk * 32 + fq * 8 + j) * LP + (16 * wave + fr) * 2);
                bfr[kk] = t; }
            float wl[4][8];
#pragma unroll
            for (int kk = 0; kk < 4; ++kk)
#pragma unroll
                for (int j = 0; j < 8; ++j) { const int l = kk * 32 + fq * 8 + j; wl[kk][j] = dtv[l] * __expf(cl - cum[l]); }
            float* stp = ST + ((size_t)(c * 32 + h) * 64) * 128;
#pragma unroll
            for (int pt = 0; pt < 4; ++pt) { f32x4 acc = {0.f, 0.f, 0.f, 0.f};
#pragma unroll
                for (int kk = 0; kk < 4; ++kk) { const bf16x8 raw = *(LAS bf16x8*)(lds + XT_OFF + (pt * 16 + fr) * LP + (kk * 32 + fq * 8) * 2); float v[8];
#pragma unroll
                    for (int j = 0; j < 8; ++j) v[j] = bf2f((unsigned short)raw[j]) * wl[kk][j];
                    acc = MFMA16(bfr[kk], pack8(v), acc); }
                *(f32x4*)(stp + (size_t)(pt * 16 + fr) * 128 + 16 * wave + fq * 4) = acc; }
        }
#undef P5A_LOAD
    }
    GRID_SYNC(); STAMP(6);

    { PHASE_IDS
        for (int e = bid * 512 + tid; e < NHEAD * 64 * 128 / 2; e += G * 512) {
            const int h = e / (64 * 128 / 2);
            f32x2 carry = {0.f, 0.f};
            f32x2* p = (f32x2*)ST + e;
#pragma unroll 8
            for (int c = 0; c < 64; ++c) { const f32x2 v = p[(size_t)c * (NHEAD * 64 * 128 / 2)]; const float d = CDEC[c * 32 + h]; p[(size_t)c * (NHEAD * 64 * 128 / 2)] = carry; carry = carry * d + v; }
        }
    }
    GRID_SYNC(); STAMP(7);

    { PHASE_IDS
        constexpr int XT_OFF = 0, BP_OFF = 64 * LP, CP_OFF = BP_OFF + 128 * LP, MM_OFF = CP_OFF + 128 * LP, SC_OFF = MM_OFF + 128 * LP, PV_OFF = SC_OFF + 1024;
        static_assert(PV_OFF + 64 * LP <= LDS_BYTES - 128, "P7 LDS map");
        LAS float* dtv = (LAS float*)(lds + SC_OFF); LAS float* cum = dtv + 128;
        const float* dskip = ((const float*)inp[14]); const float* snw = ((const float*)inp[15]);
        const float* dtb = ((const float*)inp[12]); const float* alog = ((const float*)inp[13]);
        constexpr int NU = 64 * 8;
        u32x4 rx[2], rbc[8]; f32x4 rp[4]; float rd0 = 0.f, rd1 = 0.f;
        const int bccol = ((tid & 31) < 16) ? (tid & 31) * 8 : 1024 + ((tid & 31) - 16) * 8;
#define P7_BC_LOAD(UN) do { const int g_ = (UN) & 7, t_ = ((UN) >> 3) * 128; \
            _Pragma("unroll") for (int k = 0; k < 8; ++k) rbc[k] = *(const u32x4*)(P + (size_t)(t_ + (tid >> 5) + 16 * k) * PW + PX0 + 2048 + g_ * 128 + bccol); } while (0)
#define P7_H_LOAD(UN, R) do { const int h_ = ((UN) & 7) * 4 + (R), c_ = (UN) >> 3, t_ = c_ * 128; \
            _Pragma("unroll") for (int k = 0; k < 2; ++k) rx[k] = *(const u32x4*)(P + (size_t)(t_ + (tid >> 3) + 64 * k) * PW + PX0 + h_ * 64 + (tid & 7) * 8); \
            _Pragma("unroll") for (int k = 0; k < 4; ++k) rp[k] = ((const f32x4*)(ST + (size_t)(c_ * 32 + h_) * 64 * 128))[tid + 512 * k]; \
            rd0 = DT[(size_t)(t_ + 2 * lane) * 32 + h_]; rd1 = DT[(size_t)(t_ + 2 * lane + 1) * 32 + h_]; } while (0)
#define P7_H_STAGE(H) do { if (wave == 0) dt_cum_r(rd0, rd1, (H), dtb, alog, dtv, cum, lane); \
            _Pragma("unroll") for (int k = 0; k < 2; ++k) { LAS unsigned char* dst = lds + XT_OFF + ((tid & 7) * 8) * LP + ((tid >> 3) + 64 * k) * 2; SCATTER8(dst, rx[k]); } \
            _Pragma("unroll") for (int k = 0; k < 4; ++k) { u32x2 o; o.x = cvt_pk_bf16(rp[k][0], rp[k][1]); o.y = cvt_pk_bf16(rp[k][2], rp[k][3]); \
                *(LAS u32x2*)(lds + PV_OFF + ((tid >> 5) + 16 * k) * LP + (tid & 31) * 8) = o; } } while (0)
        for (int unit = bid; unit < NU; unit += G) {
            const int c = unit >> 3, g = unit & 7, tok0 = c * 128;
            P7_BC_LOAD(unit); P7_H_LOAD(unit, 0);
            __syncthreads();
#pragma unroll
            for (int k = 0; k < 8; ++k) *(LAS u32x4*)(lds + ((tid & 31) < 16 ? BP_OFF + (tid & 31) * 16 : CP_OFF + ((tid & 31) - 16) * 16) + ((tid >> 5) + 16 * k) * LP) = rbc[k];
            P7_H_STAGE(4 * g);
            P7_H_LOAD(unit, 1);
            __syncthreads();
            bf16x8 cfr[4];
#pragma unroll
            for (int kk = 0; kk < 4; ++kk) cfr[kk] = *(LAS bf16x8*)(lds + CP_OFF + (16 * wave + fr) * LP + (kk * 32 + fq * 8) * 2);
            const int l = 16 * wave + fr; const int tok = tok0 + l;
            f32x4 sacc[8];
#pragma unroll
            for (int st = 0; st < 8; ++st) { f32x4 acc = {0.f, 0.f, 0.f, 0.f};
#pragma unroll
                for (int kk = 0; kk < 4; ++kk) { const bf16x8 a = *(LAS bf16x8*)(lds + BP_OFF + (st * 16 + fr) * LP + (kk * 32 + fq * 8) * 2); acc = MFMA16(a, cfr[kk], acc); }
                sacc[st] = acc; }
#pragma unroll
            for (int r = 0; r < 4; ++r) { const int h = 4 * g + r;
                if (r > 0) { __syncthreads(); P7_H_STAGE(h);
                    if (r < 3) P7_H_LOAD(unit, r + 1);
                    __syncthreads(); }
                const float cl = cum[l];
#pragma unroll
                for (int st = 0; st < 8; ++st) { float mv[4];
#pragma unroll
                    for (int j = 0; j < 4; ++j) { const int sx = st * 16 + fq * 4 + j; mv[j] = (sx <= l) ? sacc[st][j] * __expf(cl - cum[sx]) * dtv[sx] : 0.f; }
                    u32x2 o; o.x = cvt_pk_bf16(mv[0], mv[1]); o.y = cvt_pk_bf16(mv[2], mv[3]);
                    *(LAS u32x2*)(lds + MM_OFF + l * LP + (st * 16 + fq * 4) * 2) = o; }
                asm volatile("s_waitcnt lgkmcnt(0)" ::: "memory");
                bf16x8 mfr[4];
#pragma unroll
                for (int kk = 0; kk < 4; ++kk) mfr[kk] = *(LAS bf16x8*)(lds + MM_OFF + l * LP + (kk * 32 + fq * 8) * 2);
                const float ecl = __expf(cl), dsk = dskip[h];
                float ss = 0.f;
#pragma unroll
                for (int pt = 0; pt < 4; ++pt) { f32x4 ad = {0.f, 0.f, 0.f, 0.f}, ao = {0.f, 0.f, 0.f, 0.f};
#pragma unroll
                    for (int kk = 0; kk < 4; ++kk) { const bf16x8 a = *(LAS bf16x8*)(lds + XT_OFF + (pt * 16 + fr) * LP + (kk * 32 + fq * 8) * 2); ad = MFMA16(a, mfr[kk], ad);
                        const bf16x8 pa = *(LAS bf16x8*)(lds + PV_OFF + (pt * 16 + fr) * LP + (kk * 32 + fq * 8) * 2); ao = MFMA16(pa, cfr[kk], ao); }
                    const int p0i = pt * 16 + fq * 4;
                    bf16_t* zp = P + (size_t)tok * PW + PZ0 + h * 64 + p0i;
                    const u32x2 zz = *(const u32x2*)zp; const float zf[4] = {bflo(zz.x), bfhi(zz.x), bflo(zz.y), bfhi(zz.y)};
                    const f32x4 nw = *(const f32x4*)(snw + h * 64 + p0i);
                    float yv[4];
#pragma unroll
                    for (int j = 0; j < 4; ++j) { const float xv = bf2f(*(LAS unsigned short*)(lds + XT_OFF + (p0i + j) * LP + l * 2));
                        const float y = (ad[j] + ecl * ao[j] + dsk * xv) * zf[j]; ss += y * y; yv[j] = y * nw[j]; }
                    u32x2 o; o.x = cvt_pk_bf16(yv[0], yv[1]); o.y = cvt_pk_bf16(yv[2], yv[3]);
                    *(u32x2*)zp = o; }
                ss += __shfl_xor(ss, 16); ss += __shfl_xor(ss, 32);
                if (fq == 0) YPART[(size_t)tok * 32 + h] = ss;
            }
        }
#undef P7_BC_LOAD
#undef P7_H_LOAD
#undef P7_H_STAGE
    }
    GRID_SYNC(); STAMP(8);

    {
        pg8::StaticOrder S; S.init(SEQ, DM, G, bid);
        const CAS gfptr* inp = (const CAS gfptr*)__builtin_amdgcn_kernarg_segment_ptr();
        LAS float* rsl = (LAS float*)(lds + 131072); prep_rstd(S, YPART, rsl);
        pg8::Gemm g{P + PZ0, WOUTA, SEQ, DM, 2 * DM, PW, 32, (long)(PU0 - PZ0 - DM) * 2};
        pg8::EpiResidMid E; E.base = HB; E.out = HB; E.ldc = DM; E.alpha = 1.0f; E.part = nullptr; E.xn = nullptr; E.nw = nullptr; E.npart = NPB; E.rsl = rsl;
        pg8::gemm_phase<pg8::EpiResidMid, pg8::StaticOrder, true>(lds, g, S, E);
    }
    GRID_SYNC(); STAMP(9);


    {
        pg8::Gemm g{HB, WQ, SEQ, DM, DM, DM}; pg8::StaticOrder S; S.init(SEQ, DM, G, bid);
        LAS float* rsl = (LAS float*)(lds + 131072); prep_rstd(S, NPB, rsl);
        pg8::EpiBf16 E{QB, DM, 0.044194173824159216f, rsl};
        pg8::gemm_phase<pg8::EpiBf16, pg8::StaticOrder, true>(lds, g, S, E);
    }
    GRID_SYNC(); STAMP(11);

    { PHASE_IDS
        constexpr int KP = 272, VP = 528, PP = 528, PBUF = 69632;
        LAS unsigned char* pw = lds + PBUF + wave * 8448;
        for (int uu = bid; uu < REPU_P11 * 64 * 4; uu += G) { const int unit = uu % (64 * 4);
            const int tb = unit >> 2, h = unit & 3, t0 = tb * 128 + 16 * wave;
            __syncthreads();
            u32x4 stg[8];
#define LOADK(c) do { _Pragma("unroll") for (int i = 0; i < 8; ++i) stg[i] = *(const u32x4*)(KB + (size_t)((tid >> 4) + 32 * i) * DM + h * 512 + (c) * 128 + (tid & 15) * 8); } while (0)
#define STOREK() do { _Pragma("unroll") for (int i = 0; i < 8; ++i) *(LAS u32x4*)(lds + ((tid >> 4) + 32 * i) * KP + (tid & 15) * 16) = stg[i]; } while (0)
#define LOADV(v) do { _Pragma("unroll") for (int i = 0; i < 8; ++i) stg[i] = *(const u32x4*)(VT + (size_t)(h * 512 + (v) * 128 + (tid >> 5) + 16 * i) * 256 + (tid & 31) * 8); } while (0)
#define STOREV() do { _Pragma("unroll") for (int i = 0; i < 8; ++i) *(LAS u32x4*)(lds + ((tid >> 5) + 16 * i) * VP + (tid & 31) * 16) = stg[i]; } while (0)
            LOADK(0);
            bf16x8 qf[16];
#pragma unroll
            for (int kk = 0; kk < 16; ++kk) qf[kk] = *(const bf16x8*)(QB + (size_t)(t0 + fr) * DM + h * 512 + kk * 32 + fq * 8);
            STOREK();
            __syncthreads();
            f32x4 sacc[16];
#pragma unroll
            for (int mt = 0; mt < 16; ++mt) sacc[mt] = (f32x4){0.f, 0.f, 0.f, 0.f};
#pragma unroll
            for (int c = 0; c < 4; ++c) {
                if (c < 3) LOADK(c + 1); else LOADV(0);
#pragma unroll
                for (int mt = 0; mt < 16; ++mt)
#pragma unroll
                    for (int kk = 0; kk < 4; ++kk) { const bf16x8 a = *(LAS bf16x8*)(lds + (mt * 16 + fr) * KP + (kk * 32 + fq * 8) * 2); sacc[mt] = MFMA16(a, qf[c * 4 + kk], sacc[mt]); }
                __syncthreads();
                if (c < 3) STOREK(); else STOREV();
                __syncthreads();
            }
            float mx = -3.0e38f;
#pragma unroll
            for (int mt = 0; mt < 16; ++mt)
#pragma unroll
                for (int j = 0; j < 4; ++j) mx = fmaxf(mx, sacc[mt][j]);
            mx = fmaxf(mx, __shfl_xor(mx, 16)); mx = fmaxf(mx, __shfl_xor(mx, 32));
            float sum = 0.f;
#pragma unroll
            for (int mt = 0; mt < 16; ++mt)
#pragma unroll
                for (int j = 0; j < 4; ++j) { const float e = __expf(sacc[mt][j] - mx); sacc[mt][j] = e; sum += e; }
            sum += __shfl_xor(sum, 16); sum += __shfl_xor(sum, 32);
            const float inv = 1.0f / sum;
#pragma unroll
            for (int mt = 0; mt < 16; ++mt) { u32x2 o; o.x = cvt_pk_bf16(sacc[mt][0] * inv, sacc[mt][1] * inv); o.y = cvt_pk_bf16(sacc[mt][2] * inv, sacc[mt][3] * inv);
                *(LAS u32x2*)(pw + fr * PP + (mt * 16 + fq * 4) * 2) = o; }
            asm volatile("s_waitcnt lgkmcnt(0)" ::: "memory");
            bf16x8 pf[8];
#pragma unroll
            for (int kk = 0; kk < 8; ++kk) pf[kk] = *(LAS bf16x8*)(pw + fr * PP + (kk * 32 + fq * 8) * 2);
#pragma unroll
            for (int v = 0; v < 4; ++v) {
                if (v < 3) LOADV(v + 1);
#pragma unroll
                for (int dt = 0; dt < 8; ++dt) { f32x4 acc = {0.f, 0.f, 0.f, 0.f};
#pragma unroll
                    for (int kk = 0; kk < 8; ++kk) { const bf16x8 a = *(LAS bf16x8*)(lds + (dt * 16 + fr) * VP + (kk * 32 + fq * 8) * 2); acc = MFMA16(a, pf[kk], acc); }
                    u32x2 o; o.x = cvt_pk_bf16(acc[0], acc[1]); o.y = cvt_pk_bf16(acc[2], acc[3]);
                    *(u32x2*)(OB + (size_t)(t0 + fr) * DM + h * 512 + v * 128 + dt * 16 + fq * 4) = o; }
                if (v < 3) { __syncthreads(); STOREV(); __syncthreads(); }
            }
#undef LOADK
#undef STOREK
#undef LOADV
#undef STOREV
        }
    }
    GRID_SYNC(); STAMP(12);

    {
        pg8::Gemm g{OB, WO, SEQ, DM, DM, DM}; pg8::StaticOrder S; S.init(SEQ, DM, G, bid);
        const CAS gfptr* inp = (const CAS gfptr*)__builtin_amdgcn_kernarg_segment_ptr();
        pg8::EpiResid<false> E{HB, HB, DM, 1.0f, nullptr, nullptr, nullptr, NPC};
        pg8::gemm_phase<pg8::EpiResid<false>, pg8::StaticOrder, true>(lds, g, S, E);
    }
    GRID_SYNC(); STAMP(13);


    {
        pg8::Gemm g{HB, WGU2, SEQ, 2 * DFF, DM, DM}; pg8::StaticOrder S; S.init(SEQ, 2 * DFF, G, bid);
        LAS float* rsl = (LAS float*)(lds + 131072); prep_rstd(S, NPC, rsl);
        pg8::EpiSwiGLU E{ACT2, DFF, rsl};
        pg8::gemm_phase<pg8::EpiSwiGLU, pg8::StaticOrder, true>(lds, g, S, E);
        { PHASE_IDS
            const int ntile = 32 * 44, full = (ntile + G - 1) / G, istart = ntile - (full - 1) * G; const bool all = istart >= G;
            __syncthreads();
            if (all || bid >= istart) CONVERT_RANGE(CV_P4_END, CV_END, (all ? bid : bid - istart), (all ? G : G - istart)); }
    }
    GRID_SYNC(); STAMP(15);

    if (G == 256) {
        const CAS gfptr* inp = (const CAS gfptr*)__builtin_amdgcn_kernarg_segment_ptr();
        pg8::Gemm g{ACT2, WD2, SEQ, DM, DFF, DFF}; pg8::StaticOrder S; S.init(SEQ, DM, G, bid);
        pg8::EpiFinal E{HB, args.out, DM, 0.5f, ((const float*)inp[25]), (float*)(ws + 65536), (unsigned*)(ws + 16384), (LAS float*)(lds + 131072)};
        pg8::gemm_phase<pg8::EpiFinal, pg8::StaticOrder, true>(lds, g, S, E);
    } else {
        {
            pg8::Gemm g{ACT2, WD2, SEQ, DM, DFF, DFF}; pg8::StaticOrder S; S.init(SEQ, DM, G, bid);
            pg8::EpiResid<false> E{HB, HB, DM, 0.5f, nullptr, nullptr, nullptr, nullptr};
            pg8::gemm_phase<pg8::EpiResid<false>, pg8::StaticOrder, true>(lds, g, S, E);
        }
        GRID_SYNC(); STAMP(16);
        { PHASE_IDS
        for (int m = gw; m < SEQ; m += NGW) norm_row_from_bf16(HB + (size_t)m * DM, ((const float*)inp[25]), args.out + (size_t)m * DM, lane);
        }
    }
}

extern "C" void kernel_launch(void* const* d_in, const int* in_sizes, int n_in, void* d_out, int out_size, void* d_ws, size_t ws_size, hipStream_t stream) {
    static int grid = 0;
    if (grid == 0) {
        if (n_in != 26 || out_size != SEQ * DM || ws_size < WS_END) { fprintf(stderr, "kernel_launch: unexpected shapes (n_in %d out %d ws %zu)\n", n_in, out_size, ws_size); grid = -1; return; }
        int dev = 0, cus = 0, per_cu = 0;
        if (hipGetDevice(&dev) != hipSuccess || hipDeviceGetAttribute(&cus, hipDeviceAttributeMultiprocessorCount, dev) != hipSuccess) { grid = -1; return; }
        if (hipFuncSetAttribute((const void*)mega_fwd, hipFuncAttributeMaxDynamicSharedMemorySize, LDS_BYTES) != hipSuccess) { fprintf(stderr, "kernel_launch: hipFuncSetAttribute failed\n"); grid = -1; return; }
        if (hipOccupancyMaxActiveBlocksPerMultiprocessor(&per_cu, (const void*)mega_fwd, 512, LDS_BYTES) != hipSuccess || per_cu < 1) { fprintf(stderr, "kernel_launch: occupancy query failed (%d)\n", per_cu); (void)hipGetLastError(); per_cu = 1; }
        grid = cus * (per_cu < 1 ? 1 : 1);
    }
    if (grid < 0) return;
    if (hipMemsetAsync(d_ws, 0, 32768, stream) != hipSuccess) { fprintf(stderr, "kernel_launch: memset failed\n"); return; }
    Args a{};
    for (int i = 0; i < 26; ++i) a.in[i] = (const float*)d_in[i];
    a.out = (float*)d_out; a.ws = (unsigned char*)d_ws;
    void* kargs[] = {&a};
    hipError_t e = hipLaunchCooperativeKernel((const void*)mega_fwd, dim3(grid), dim3(512), kargs, LDS_BYTES, stream);
    if (e != hipSuccess) fprintf(stderr, "cooperative launch failed: %s (grid %d)\n", hipGetErrorString(e), grid);
}
```

```cpp
#include <hip/hip_runtime.h>
#include <hip/hip_cooperative_groups.h>
#include <cstdio>
#include <cstdint>
namespace cg = cooperative_groups;

#define LAS __attribute__((address_space(3)))
#define CAS __attribute__((address_space(4)))
typedef const __attribute__((address_space(1))) float* gfptr;
typedef unsigned short bf16_t;
typedef short bf16x8 __attribute__((ext_vector_type(8)));
typedef float f32x4 __attribute__((ext_vector_type(4)));
typedef float f32x2 __attribute__((ext_vector_type(2)));
typedef unsigned u32x4 __attribute__((ext_vector_type(4)));
typedef unsigned u32x2 __attribute__((ext_vector_type(2)));

constexpr int SEQ = 8192, DM = 2048, DFF = 5632, MEML = 256;
constexpr int NHEAD = 32, PW = 10240;
constexpr int PU0 = 0, PZ0 = 2048, PV0 = 4096, PX0 = 6144;
constexpr float EPS = 1e-6f;

constexpr size_t MiB = 1u << 20;
constexpr size_t WS_WGU1 = 1 * MiB, WS_WD1 = 45 * MiB, WS_WIN = 67 * MiB, WS_WOUTA = 108 * MiB, WS_WOUTM = 116 * MiB,
                 WS_WQ = 124 * MiB, WS_WKV = 132 * MiB, WS_WO = 148 * MiB, WS_WGU2 = 156 * MiB, WS_WD2 = 200 * MiB,
                 WS_XN = 222 * MiB, WS_P = 254 * MiB, WS_ST = 414 * MiB, WS_DT = 478 * MiB, WS_VPART = 479 * MiB,
                 WS_YPART = 480 * MiB, WS_CDEC = 481 * MiB, WS_KB = 482 * MiB, WS_VT = 483 * MiB, WS_MEMN = 484 * MiB,
                 WS_HALO = 489 * MiB, WS_NPA = 485 * MiB, WS_NPB = 486 * MiB, WS_NPC = 487 * MiB, WS_NPD = 488 * MiB,
                 WS_END = 495 * MiB;
constexpr size_t WS_ACT = WS_P;
constexpr size_t WS_Q = WS_P, WS_O = WS_P + 32 * MiB, WS_ACT2 = WS_P + 64 * MiB;

constexpr int LDS_BYTES = 147456;
#ifndef PROBE_A
#define PROBE_A -1
#define PROBE_B -1
#endif
#ifndef REP_P0
#define REPU_P5A 1
#define REPU_P7 1
#define REPU_P5B 1
#define REPU_P11 1
#define REPG_P4 1
#define REPG_P2 1
#define REP_SYNC 1
#endif
#ifndef STOP_AFTER
#define STOP_AFTER 99
#endif

typedef __bf16 bf16x2_t __attribute__((ext_vector_type(2)));
__device__ __forceinline__ unsigned cvt_pk_bf16(float lo, float hi) { typedef float f2 __attribute__((ext_vector_type(2))); f2 v = {lo, hi}; bf16x2_t b = __builtin_convertvector(v, bf16x2_t); return __builtin_bit_cast(unsigned, b); }
__device__ __forceinline__ float bflo(unsigned u) { return __uint_as_float(u << 16); }
__device__ __forceinline__ float bfhi(unsigned u) { return __uint_as_float(u & 0xffff0000u); }
__device__ __forceinline__ float bf2f(unsigned short h) { return __uint_as_float(((unsigned)h) << 16); }
__device__ __forceinline__ float silu_f(float x) { return x * __builtin_amdgcn_rcpf(1.0f + __expf(-x)); }
__device__ __forceinline__ float gelu_f(float x) { const float y = 0.7978845608028654f * (x + 0.044715f * x * x * x); return x * __builtin_amdgcn_rcpf(1.0f + __expf(-2.0f * y)); }
__device__ __forceinline__ float wave_sum(float v) {
#pragma unroll
    for (int o = 1; o < 64; o <<= 1) v += __shfl_xor(v, o);
    return v;
}
__device__ __forceinline__ bf16x8 pack8(const float (&v)[8]) {
    u32x4 w; w.x = cvt_pk_bf16(v[0], v[1]); w.y = cvt_pk_bf16(v[2], v[3]); w.z = cvt_pk_bf16(v[4], v[5]); w.w = cvt_pk_bf16(v[6], v[7]);
    return __builtin_bit_cast(bf16x8, w);
}

namespace pg8 {
constexpr int BM = 256, BK = 64, HALF = 128, HTB = HALF * BK * 2, STAGE_BYTES = 8 * HTB, NXCD = 8, WGM = 8;
__host__ __device__ __forceinline__ int lds_byte(int r, int c) { const int st = (r >> 4) * 2 + (c >> 5), rr = r & 15, cc = c & 31, ob = rr * 64 + cc * 2; return st * 1024 + (ob ^ (((ob >> 9) & 1) << 5)); }
__host__ __device__ __forceinline__ void stage_rc(int b, int& R, int& C) { const int st = b / 1024, sb = b % 1024, swz = sb ^ (((sb >> 9) & 1) << 5); R = (st >> 1) * 16 + swz / 64; C = (st & 1) * 32 + (swz % 64) / 2; }
__host__ __device__ __forceinline__ int perm32(int rho) { const int n = rho >> 4, i = rho & 15; return 8 * (i >> 2) + 4 * n + (i & 3); }

struct Unit { int pm, pn; };
struct Gemm { const bf16_t* A; const bf16_t* Bt; int M, N, K, lda; int ks = 1 << 30; long ashift = 0; };

struct StaticOrder {
    int nM, nN, nwg, G, c, rep = 1;
    __host__ __device__ void init(int M, int N, int G_, int c_) { nM = M / BM; nN = N / BM; nwg = nM * nN; G = G_; c = c_; }
    __host__ __device__ bool next(int i, Unit& u) const {
        const long L = (long)i * G + c; if (L >= (long)nwg * rep) return false;
        int wgid = (int)L; if (rep > 1) { while (wgid >= nwg) wgid -= nwg; } { const int q = nwg / NXCD, r = nwg % NXCD, xcd = wgid % NXCD, off = wgid / NXCD; wgid = (xcd < r ? xcd * (q + 1) : r * (q + 1) + (xcd - r) * q) + off; }
        const int nig = WGM * nN, gid = wgid / nig, fm = gid * WGM, gsz = (nM - fm) < WGM ? (nM - fm) : WGM;
        u.pm = fm + ((wgid % nig) % gsz); u.pn = (wgid % nig) / gsz; return true;
    }
};

template <class Epi, class Sched, bool ALIGN_EPI>
__device__ __forceinline__ void gemm_phase(LAS unsigned char* lds, const Gemm g, const Sched& S, const Epi& E) {
    int tid = threadIdx.x; asm volatile("" : "+v"(tid));
    const int wid = __builtin_amdgcn_readfirstlane(tid >> 6), lane = tid & 63, wr = wid >> 2, wc = wid & 3, fr = lane & 15, fq = lane >> 4;
    const int K = g.K, nt = K / BK, lda = g.lda;
    unsigned voffA[2], voffB[2];
#pragma unroll
    for (int i = 0; i < 2; ++i) { int R, C; stage_rc(tid * 16 + i * 8192, R, C); const int Rb = Epi::PERM ? ((R & ~31) + perm32(R & 31)) : R;
        voffA[i] = (unsigned)(R * lda + C) * 2u; voffB[i] = (unsigned)(Rb * K + C) * 2u; }
    const size_t kstep = (size_t)(BK * 2);
    const size_t hstepA = (size_t)HALF * lda * 2, hstepB = (size_t)HALF * K * 2;
    const size_t tstepA = 2 * hstepA, tstepB = 2 * hstepB;
    const unsigned ldsw = (unsigned)wid * 1024u;
    const int aoff = lds_byte(wr * 64 + fr, fq * 8), boff = lds_byte(wc * 32 + fr, fq * 8);
#define PG8_SA(b, h) (((b) * 2 + (h)) * HTB)
#define PG8_SB(b, h) ((4 + (b) * 2 + (h)) * HTB)
#define PG8_STAGE(bufoff, gbase, voff) do { _Pragma("unroll") for (int _i = 0; _i < 2; ++_i) \
        __builtin_amdgcn_global_load_lds((const unsigned*)((const char*)(gbase) + (voff)[_i]), (LAS unsigned*)(lds + (bufoff) + ldsw + _i * 8192), 16, 0, 0); } while (0)
#define PG8_LDA(dst, b, h) do { _Pragma("unroll") for (int m = 0; m < 4; ++m) _Pragma("unroll") for (int k = 0; k < 2; ++k) dst[m][k] = *(const LAS bf16x8*)(lds + PG8_SA(b, h) + aoff + m * 2048 + k * 1024); } while (0)
#define PG8_LDB(dst, b, h) do { _Pragma("unroll") for (int n = 0; n < 2; ++n) _Pragma("unroll") for (int k = 0; k < 2; ++k) dst[n][k] = *(const LAS bf16x8*)(lds + PG8_SB(b, h) + boff + n * 2048 + k * 1024); } while (0)
#define PG8_MMA(ai, bj, At, Bt) do { __builtin_amdgcn_s_setprio(1); _Pragma("unroll") for (int m = 0; m < 4; ++m) _Pragma("unroll") for (int n = 0; n < 2; ++n) _Pragma("unroll") for (int k = 0; k < 2; ++k) \
        acc[ai][bj][m][n] = __builtin_amdgcn_mfma_f32_16x16x32_bf16(Bt[n][k], At[m][k], acc[ai][bj][m][n], 0, 0, 0); __builtin_amdgcn_s_setprio(0); } while (0)
#define PG8_WAIT_V(n) asm volatile("s_waitcnt vmcnt(" #n ")" ::: "memory")
#define PG8_WAIT_L(n) asm volatile("s_waitcnt lgkmcnt(" #n ")" ::: "memory")
#define PG8_BAR __builtin_amdgcn_s_barrier()
#define PG8_SCHED __builtin_amdgcn_sched_barrier(0)
    Unit cur, nxt; int ui = 0;
    if (!S.next(0, cur)) return;
    f32x4 acc[2][2][4][2];
#pragma unroll
    for (int a = 0; a < 2; ++a)
#pragma unroll
        for (int b = 0; b < 2; ++b)
#pragma unroll
            for (int m = 0; m < 4; ++m)
#pragma unroll
                for (int n = 0; n < 2; ++n) acc[a][b][m][n] = (f32x4){0.f, 0.f, 0.f, 0.f};
    bf16x8 At[4][2], B0[2][2], B1[2][2];
    const char* cA = (const char*)g.A + (size_t)cur.pm * tstepA; const char* cB = (const char*)g.Bt + (size_t)cur.pn * tstepB;
    PG8_STAGE(PG8_SB(0, 0), cB, voffB); PG8_STAGE(PG8_SB(0, 1), cB + hstepB, voffB); PG8_STAGE(PG8_SA(0, 0), cA, voffA); PG8_STAGE(PG8_SA(0, 1), cA + hstepA, voffA);
    if (wr == 1) PG8_BAR;
    PG8_WAIT_V(2); PG8_BAR;
    PG8_STAGE(PG8_SB(1, 0), cB + kstep, voffB); PG8_STAGE(PG8_SA(1, 0), cA + kstep, voffA); PG8_STAGE(PG8_SB(1, 1), cB + hstepB + kstep, voffB);
    PG8_WAIT_V(6); PG8_BAR;
    for (;;) {
        const bool has_next = S.next(ui + 1, nxt);
        const char* nA = has_next ? (const char*)g.A + (size_t)nxt.pm * tstepA : cA; const char* nB = has_next ? (const char*)g.Bt + (size_t)nxt.pn * tstepB : cB;
        for (int t = 0; t < nt; t += 2) {
            const bool last = (t == nt - 2);
            if constexpr (Epi::MIDK) { if (t == g.ks) E.mid(acc, cur, ui, wr, wc, fr, fq); }
            const long sh1 = (t >= g.ks) ? g.ashift : 0, sh2 = (t + 2 >= g.ks) ? g.ashift : 0;
            const char* a1 = cA + (size_t)(t + 1) * kstep + sh1;
            const char* a2 = last ? nA : cA + (size_t)(t + 2) * kstep + sh2; const char* b2 = last ? nB : cB + (size_t)(t + 2) * kstep;
            const char* a3 = a2 + kstep; const char* b3 = b2 + kstep;
            PG8_LDB(B0, 0, 0); PG8_LDB(B1, 0, 1); PG8_SCHED; PG8_LDA(At, 0, 0); PG8_STAGE(PG8_SA(1, 1), a1 + hstepA, voffA);
            PG8_WAIT_V(8); PG8_WAIT_L(0); PG8_BAR; PG8_MMA(0, 0, At, B0); PG8_MMA(0, 1, At, B1); PG8_BAR; PG8_SCHED;
            PG8_LDA(At, 0, 1); PG8_STAGE(PG8_SB(0, 0), b2, voffB); PG8_STAGE(PG8_SB(0, 1), b2 + hstepB, voffB); PG8_STAGE(PG8_SA(0, 0), a2, voffA);
            PG8_WAIT_V(8); PG8_WAIT_L(0); PG8_BAR; PG8_MMA(1, 0, At, B0); PG8_MMA(1, 1, At, B1); PG8_BAR; PG8_SCHED;
            PG8_LDB(B0, 1, 0); PG8_LDB(B1, 1, 1); PG8_SCHED; PG8_LDA(At, 1, 0); PG8_STAGE(PG8_SA(0, 1), a2 + hstepA, voffA);
            PG8_WAIT_V(8); PG8_WAIT_L(0); PG8_BAR; PG8_MMA(0, 0, At, B0); PG8_MMA(0, 1, At, B1); PG8_BAR; PG8_SCHED;
            PG8_LDA(At, 1, 1); PG8_STAGE(PG8_SB(1, 0), b3, voffB); PG8_STAGE(PG8_SB(1, 1), b3 + hstepB, voffB); PG8_STAGE(PG8_SA(1, 0), a3, voffA);
            PG8_WAIT_V(8); PG8_WAIT_L(0); PG8_BAR; PG8_MMA(1, 0, At, B0); PG8_MMA(1, 1, At, B1); PG8_BAR; PG8_SCHED;
        }
        if constexpr (ALIGN_EPI) { if (wr == 0) PG8_BAR; }
        E(acc, cur, ui, wr, wc, fr, fq);
        if (!has_next) break;
#pragma unroll
        for (int a = 0; a < 2; ++a)
#pragma unroll
            for (int b = 0; b < 2; ++b)
#pragma unroll
                for (int m = 0; m < 4; ++m)
#pragma unroll
                    for (int n = 0; n < 2; ++n) acc[a][b][m][n] = (f32x4){0.f, 0.f, 0.f, 0.f};
        cur = nxt; cA = nA; cB = nB; ++ui;
        if constexpr (ALIGN_EPI) { if (wr == 1) PG8_BAR; }
    }
    PG8_WAIT_V(0);
    if constexpr (!ALIGN_EPI) { if (wr == 0) PG8_BAR; }
    PG8_BAR;
#undef PG8_SA
#undef PG8_SB
#undef PG8_STAGE
#undef PG8_LDA
#undef PG8_LDB
#undef PG8_MMA
#undef PG8_WAIT_V
#undef PG8_WAIT_L
#undef PG8_BAR
#undef PG8_SCHED
}

__device__ __forceinline__ float row_rstd(const float* part, int row, int fq) {
    const f32x4 p0 = *(const f32x4*)(part + (size_t)row * 32 + fq * 8), p1 = *(const f32x4*)(part + (size_t)row * 32 + fq * 8 + 4);
    float s = (p0[0] + p0[1]) + (p0[2] + p0[3]) + (p1[0] + p1[1]) + (p1[2] + p1[3]); s += __shfl_xor(s, 16); s += __shfl_xor(s, 32);
    return rsqrtf(s * (1.0f / 2048.0f) + EPS);
}
struct EpiSwiGLU {
    static constexpr bool PERM = true, MIDK = false;
    bf16_t* O; int ldc; const LAS float* rsl;
    __device__ __forceinline__ void operator()(const f32x4 (&acc)[2][2][4][2], const Unit& u, int ui, int wr, int wc, int fr, int fq) const {
        const int row0 = u.pm * BM + wr * 64 + fr, col0 = u.pn * HALF + wc * 32 + 8 * fq;
#pragma unroll
        for (int ai = 0; ai < 2; ++ai)
#pragma unroll
            for (int m = 0; m < 4; ++m) {
                const int row = row0 + ai * HALF + m * 16;
                bf16_t* rowp = O + (size_t)row * ldc + col0;
                const float rs = rsl[ui * 256 + (row & 255)];
                float v[8];
#pragma unroll
                for (int n = 0; n < 2; ++n)
#pragma unroll
                    for (int j = 0; j < 4; ++j) v[n * 4 + j] = silu_f(acc[ai][0][m][n][j] * rs) * (acc[ai][1][m][n][j] * rs);
                u32x4 w; w.x = cvt_pk_bf16(v[0], v[1]); w.y = cvt_pk_bf16(v[2], v[3]); w.z = cvt_pk_bf16(v[4], v[5]); w.w = cvt_pk_bf16(v[6], v[7]);
                *(u32x4*)rowp = w;
            }
    }
};
template <bool BASE_F32> struct EpiResid {
    static constexpr bool PERM = true, MIDK = false;
    const void* base; bf16_t* out; int ldc; float alpha; const float* part;
    bf16_t* xn; const float* nw; float* npart;
    __device__ __forceinline__ void operator()(const f32x4 (&acc)[2][2][4][2], const Unit& u, int ui, int wr, int wc, int fr, int fq) const {
        const int col0 = u.pn * BM + wc * 32 + 8 * fq;
#pragma unroll
        for (int ai = 0; ai < 2; ++ai)
#pragma unroll
            for (int m = 0; m < 4; ++m) {
                const int row = u.pm * BM + ai * HALF + wr * 64 + m * 16 + fr;
                float sc = alpha;
                if (part) sc = alpha * row_rstd(part, row, fq);
                const size_t off = (size_t)row * ldc + col0;
                float ss = 0.f;
#pragma unroll
                for (int bj = 0; bj < 2; ++bj) { f32x4 b0, b1;
                    if (BASE_F32) { b0 = *(const f32x4*)((const float*)base + off + bj * HALF); b1 = *(const f32x4*)((const float*)base + off + bj * HALF + 4); }
                    else { const u32x4 r = *(const u32x4*)((const bf16_t*)base + off + bj * HALF); b0 = (f32x4){bflo(r.x), bfhi(r.x), bflo(r.y), bfhi(r.y)}; b1 = (f32x4){bflo(r.z), bfhi(r.z), bflo(r.w), bfhi(r.w)}; }
                    const f32x4 o0 = b0 + acc[ai][bj][m][0] * sc, o1 = b1 + acc[ai][bj][m][1] * sc;
                    u32x4 ho; ho.x = cvt_pk_bf16(o0[0], o0[1]); ho.y = cvt_pk_bf16(o0[2], o0[3]); ho.z = cvt_pk_bf16(o1[0], o1[1]); ho.w = cvt_pk_bf16(o1[2], o1[3]);
                    *(u32x4*)(out + off + bj * HALF) = ho;
                    if (npart) ss += ((o0[0] * o0[0] + o0[1] * o0[1]) + (o0[2] * o0[2] + o0[3] * o0[3])) + ((o1[0] * o1[0] + o1[1] * o1[1]) + (o1[2] * o1[2] + o1[3] * o1[3]));
                    if (xn) { const f32x4 w0 = *(const f32x4*)(nw + col0 + bj * HALF), w1 = *(const f32x4*)(nw + col0 + bj * HALF + 4);
                        u32x4 q; q.x = cvt_pk_bf16(o0[0] * w0[0], o0[1] * w0[1]); q.y = cvt_pk_bf16(o0[2] * w0[2], o0[3] * w0[3]); q.z = cvt_pk_bf16(o1[0] * w1[0], o1[1] * w1[1]); q.w = cvt_pk_bf16(o1[2] * w1[2], o1[3] * w1[3]);
                        *(u32x4*)(xn + off + bj * HALF) = q; } }
                if (npart) { ss += __shfl_xor(ss, 16); ss += __shfl_xor(ss, 32); if (fq == 0) npart[(size_t)row * 32 + u.pn * 4 + wc] = ss; }
            }
    }
};
struct EpiResidMid : EpiResid<false> {
    static constexpr bool MIDK = true;
    const LAS float* rsl;
    __device__ __forceinline__ void mid(f32x4 (&acc)[2][2][4][2], const Unit& u, int ui, int wr, int wc, int fr, int fq) const {
#pragma unroll
        for (int ai = 0; ai < 2; ++ai)
#pragma unroll
            for (int m = 0; m < 4; ++m) { const float rs = rsl[ui * 256 + ai * HALF + wr * 64 + m * 16 + fr];
#pragma unroll
                for (int bj = 0; bj < 2; ++bj)
#pragma unroll
                    for (int n = 0; n < 2; ++n) acc[ai][bj][m][n] = acc[ai][bj][m][n] * rs; }
    }
};
struct EpiBf16 {
    static constexpr bool PERM = true, MIDK = false;
    bf16_t* O; int ldc; float scale0; const LAS float* rsl;
    __device__ __forceinline__ void operator()(const f32x4 (&acc)[2][2][4][2], const Unit& u, int ui, int wr, int wc, int fr, int fq) const {
        const int row0 = u.pm * BM + wr * 64 + fr, col0 = u.pn * BM + wc * 32 + 8 * fq;
#pragma unroll
        for (int ai = 0; ai < 2; ++ai)
#pragma unroll
            for (int m = 0; m < 4; ++m) { const int row = row0 + ai * HALF + m * 16; bf16_t* rowp = O + (size_t)row * ldc + col0;
                const float scale = scale0 * rsl[ui * 256 + (row & 255)];
#pragma unroll
                for (int bj = 0; bj < 2; ++bj) { const f32x4 v0 = acc[ai][bj][m][0] * scale, v1 = acc[ai][bj][m][1] * scale;
                    u32x4 w; w.x = cvt_pk_bf16(v0[0], v0[1]); w.y = cvt_pk_bf16(v0[2], v0[3]); w.z = cvt_pk_bf16(v1[0], v1[1]); w.w = cvt_pk_bf16(v1[2], v1[3]);
                    *(u32x4*)(rowp + bj * HALF) = w; } }
    }
};
struct EpiKV {
    static constexpr bool PERM = true, MIDK = false;
    bf16_t* KB; bf16_t* VT;
    __device__ __forceinline__ void operator()(const f32x4 (&acc)[2][2][4][2], const Unit& u, int ui, int wr, int wc, int fr, int fq) const {
        const int row0 = u.pm * BM + wr * 64 + fr, col0 = u.pn * BM + wc * 32 + 8 * fq;
#pragma unroll
        for (int ai = 0; ai < 2; ++ai)
#pragma unroll
            for (int m = 0; m < 4; ++m) { const int row = row0 + ai * HALF + m * 16;
#pragma unroll
                for (int bj = 0; bj < 2; ++bj) { const int col = col0 + bj * HALF;
                    if (col < 2048) { const f32x4 v0 = acc[ai][bj][m][0], v1 = acc[ai][bj][m][1];
                        u32x4 w; w.x = cvt_pk_bf16(v0[0], v0[1]); w.y = cvt_pk_bf16(v0[2], v0[3]); w.z = cvt_pk_bf16(v1[0], v1[1]); w.w = cvt_pk_bf16(v1[2], v1[3]);
                        *(u32x4*)(KB + (size_t)row * 2048 + col) = w;
                    } else {
#pragma unroll
                        for (int n = 0; n < 2; ++n)
#pragma unroll
                            for (int j = 0; j < 4; ++j) VT[(size_t)(col - 2048 + n * 4 + j) * 256 + row] = (bf16_t)(cvt_pk_bf16(acc[ai][bj][m][n][j], 0.f) & 0xffffu);
                    } } }
    }
};
struct EpiWin {
    static constexpr bool PERM = true, MIDK = false;
    bf16_t* P; float* dt; float* vpart; const LAS float* rsl; bf16_t* halo;
    __device__ __forceinline__ void operator()(const f32x4 (&acc)[2][2][4][2], const Unit& u, int ui, int wr, int wc, int fr, int fq) const {
        const int pn = u.pn;
        const int row0 = u.pm * BM + wr * 64 + fr;
        if (pn == 40) {
            if (wc == 0) {
#pragma unroll
                for (int ai = 0; ai < 2; ++ai)
#pragma unroll
                    for (int m = 0; m < 4; ++m) { const int row = row0 + ai * HALF + m * 16; float* rp = dt + (size_t)row * 32 + 8 * fq; const float rs = rsl[ui * 256 + (row & 255)];
                        *(f32x4*)rp = acc[ai][0][m][0] * rs; *(f32x4*)(rp + 4) = acc[ai][0][m][1] * rs; }
            }
            return;
        }
        const int mode = pn < 8 ? 0 : (pn < 16 ? 1 : (pn < 24 ? 2 : 3));
        const int col0 = pn * BM + wc * 32 + 8 * fq;
#pragma unroll
        for (int ai = 0; ai < 2; ++ai)
#pragma unroll
            for (int m = 0; m < 4; ++m) { const int row = row0 + ai * HALF + m * 16; bf16_t* rowp = P + (size_t)row * PW + col0; float ss = 0.f; const float rs = rsl[ui * 256 + (row & 255)];
#pragma unroll
                for (int bj = 0; bj < 2; ++bj) { float v[8];
#pragma unroll
                    for (int n = 0; n < 2; ++n)
#pragma unroll
                        for (int j = 0; j < 4; ++j) { float x = acc[ai][bj][m][n][j] * rs;
                            if (mode == 0 || mode == 2) x = gelu_f(x); else if (mode == 1) x = silu_f(x);
                            v[n * 4 + j] = x; ss += x * x; }
                    u32x4 w; w.x = cvt_pk_bf16(v[0], v[1]); w.y = cvt_pk_bf16(v[2], v[3]); w.z = cvt_pk_bf16(v[4], v[5]); w.w = cvt_pk_bf16(v[6], v[7]);
                    *(u32x4*)(rowp + bj * HALF) = w;
                    if (mode == 3 && (row & 31) >= 29) *(u32x4*)(halo + ((size_t)(row >> 5) * 3 + (row & 31) - 29) * 4096 + (col0 + bj * HALF - PX0)) = w; }
                if (mode == 2) { ss += __shfl_xor(ss, 16); ss += __shfl_xor(ss, 32); if (fq == 0) vpart[(size_t)row * 32 + (pn - 16) * 4 + wc] = ss; }
            }
    }
};
struct EpiFinal {
    static constexpr bool PERM = false, MIDK = false;
    const bf16_t* base; float* out; int ldc; float alpha; const float* nw;
    float* slots;
    unsigned* cnt;
    LAS float* ex;
    __device__ __forceinline__ void operator()(f32x4 (&acc)[2][2][4][2], const Unit& u, int ui, int wr, int wc, int fr, int fq) const {
        const int col0 = u.pn * BM + wc * 32 + 4 * fq;
        int tid = threadIdx.x; asm volatile("" : "+v"(tid));
        LAS float* Pl = ex; LAS float* Sl = ex + 1024;
#pragma unroll
        for (int ai = 0; ai < 2; ++ai)
#pragma unroll
            for (int m = 0; m < 4; ++m) {
                const int rl = ai * HALF + wr * 64 + m * 16 + fr; const size_t off = (size_t)(u.pm * BM + rl) * ldc + col0; float ss = 0.f;
#pragma unroll
                for (int bj = 0; bj < 2; ++bj)
#pragma unroll
                    for (int n = 0; n < 2; ++n) { const u32x2 r = *(const u32x2*)(base + off + bj * HALF + n * 16); const f32x4 b = {bflo(r.x), bfhi(r.x), bflo(r.y), bfhi(r.y)}; const f32x4 o = b + acc[ai][bj][m][n] * alpha; acc[ai][bj][m][n] = o;
                        ss += (o[0] * o[0] + o[1] * o[1]) + (o[2] * o[2] + o[3] * o[3]); }
                ss += __shfl_xor(ss, 16); ss += __shfl_xor(ss, 32);
                if (fq == 0) Pl[rl * 4 + wc] = ss;
            }
        __syncthreads();
        if (tid < 256) { const float t = (Pl[tid * 4 + 0] + Pl[tid * 4 + 1]) + (Pl[tid * 4 + 2] + Pl[tid * 4 + 3]);
            __hip_atomic_store(slots + (size_t)(u.pm * BM + tid) * 8 + u.pn, t, __ATOMIC_RELAXED, __HIP_MEMORY_SCOPE_AGENT);
            asm volatile("s_waitcnt vmcnt(0)" ::: "memory");
            if ((tid & 63) == 0) __hip_atomic_fetch_add(cnt + 64 * u.pm, 1u, __ATOMIC_RELAXED, __HIP_MEMORY_SCOPE_AGENT); }
        if (tid < 64) { unsigned sp = 0;
            while (__hip_atomic_load(cnt + 64 * u.pm, __ATOMIC_RELAXED, __HIP_MEMORY_SCOPE_AGENT) < 32u) { __builtin_amdgcn_s_sleep(1); if (++sp > (1u << 22)) break; }
            __builtin_amdgcn_fence(__ATOMIC_ACQUIRE, "agent"); asm volatile("s_waitcnt vmcnt(0)" ::: "memory"); }
        __syncthreads();
        if (tid < 256) { const float* sp = slots + (size_t)(u.pm * BM + tid) * 8; float t = 0.f;
#pragma unroll
            for (int q = 0; q < 8; ++q) t += __hip_atomic_load(sp + q, __ATOMIC_RELAXED, __HIP_MEMORY_SCOPE_AGENT);
            Sl[tid] = rsqrtf(t * (1.0f / 2048.0f) + EPS); }
        __syncthreads();
#pragma unroll
        for (int ai = 0; ai < 2; ++ai)
#pragma unroll
            for (int m = 0; m < 4; ++m) { const int rl = ai * HALF + wr * 64 + m * 16 + fr; const size_t off = (size_t)(u.pm * BM + rl) * ldc + col0; const float rs = Sl[rl];
#pragma unroll
                for (int bj = 0; bj < 2; ++bj)
#pragma unroll
                    for (int n = 0; n < 2; ++n) { const f32x4 w = *(const f32x4*)(nw + col0 + bj * HALF + n * 16); __builtin_nontemporal_store(acc[ai][bj][m][n] * rs * w, (f32x4*)(out + off + bj * HALF + n * 16)); }
            }
    }
};
}

template <class Sched> __device__ __forceinline__ void prep_rstd(const Sched& S, const float* part, LAS float* rsl) {
    const int tid = threadIdx.x; pg8::Unit u;
    for (int i0 = 0; S.next(i0, u); i0 += 2) {
        const int i = i0 + (tid >> 8);
        if (S.next(i, u)) { const f32x4* pp = (const f32x4*)(part + (size_t)(u.pm * 256 + (tid & 255)) * 32); float sm = 0.f;
#pragma unroll
            for (int q = 0; q < 8; ++q) { const f32x4 t = pp[q]; sm += (t[0] + t[1]) + (t[2] + t[3]); }
            rsl[i * 256 + (tid & 255)] = rsqrtf(sm * (1.f / 2048.f) + EPS); }
    }
    __syncthreads();
}

struct Args { const float* in[26]; float* out; unsigned char* ws; };

__device__ __forceinline__ int maprow(int mode, int n0) {
    if (mode == 1) { return n0 < DFF ? (n0 / 128) * 256 + (n0 % 128) : ((n0 - DFF) / 128) * 256 + 128 + ((n0 - DFF) % 128); }
    if (mode == 2) { return (n0 >= 2048 && n0 < 4096) ? n0 + 2048 : ((n0 >= 4096 && n0 < 6144) ? n0 - 2048 : n0); }
    return n0;
}
__device__ __forceinline__ void tr_item(const float* W, int K, int N, bf16_t* WT, int mode, LAS float* scr, int item, int lane, const float* ks = nullptr) {
    const int nblk = N / 32, kb = item / nblk, nb = item % nblk, k0 = 64 * kb, n0 = 32 * nb;
    const int r0 = maprow(mode, n0);
    const int kd = (mode == 3) ? ((k0 + 2048) & 4095) : k0;
    f32x4 ld[8];
#pragma unroll
    for (int i = 0; i < 8; ++i) ld[i] = __builtin_nontemporal_load((const f32x4*)(W + (size_t)(k0 + 8 * i + (lane >> 3)) * N + n0 + (lane & 7) * 4));
    if (ks) {
#pragma unroll
        for (int i = 0; i < 8; ++i) ld[i] = ld[i] * ks[k0 + 8 * i + (lane >> 3)]; }
#pragma unroll
    for (int i = 0; i < 8; ++i) { LAS float* d = scr + (8 * i + (lane >> 3)) * 33 + (lane & 7) * 4; d[0] = ld[i][0]; d[1] = ld[i][1]; d[2] = ld[i][2]; d[3] = ld[i][3]; }
    asm volatile("s_waitcnt lgkmcnt(0)" ::: "memory");
    const int c = lane & 7;
#pragma unroll
    for (int j = 0; j < 4; ++j) { const int n = (lane >> 3) + 8 * j; const LAS float* s = scr + (8 * c) * 33 + n;
        u32x4 o; o.x = cvt_pk_bf16(s[0 * 33], s[1 * 33]); o.y = cvt_pk_bf16(s[2 * 33], s[3 * 33]); o.z = cvt_pk_bf16(s[4 * 33], s[5 * 33]); o.w = cvt_pk_bf16(s[6 * 33], s[7 * 33]);
        *(u32x4*)(WT + (size_t)(r0 + n) * K + kd + 8 * c) = o; }
    asm volatile("s_waitcnt lgkmcnt(0)" ::: "memory");
}
__device__ __forceinline__ void norm_row_bf16(const float* xrow, const float* w, bf16_t* orow, int lane) {
    const f32x4* xr = (const f32x4*)xrow + lane; const f32x4* wr = (const f32x4*)w + lane;
    f32x4 v[8]; float s = 0.f;
#pragma unroll
    for (int j = 0; j < 8; ++j) { v[j] = xr[64 * j]; s += (v[j].x * v[j].x + v[j].y * v[j].y) + (v[j].z * v[j].z + v[j].w * v[j].w); }
    const float rstd = rsqrtf(wave_sum(s) * (1.f / 2048.f) + EPS);
    u32x2* o8 = (u32x2*)orow + lane;
#pragma unroll
    for (int j = 0; j < 8; ++j) { const f32x4 ww = wr[64 * j]; u32x2 o; o.x = cvt_pk_bf16(v[j].x * rstd * ww.x, v[j].y * rstd * ww.y); o.y = cvt_pk_bf16(v[j].z * rstd * ww.z, v[j].w * rstd * ww.w); o8[64 * j] = o; }
}
__device__ __forceinline__ void wrow_bf16(const float* xrow, bf16_t* orow, float* part, int lane) {
    const f32x4* xr = (const f32x4*)xrow + lane;
    f32x4 v[8]; float s = 0.f;
#pragma unroll
    for (int j = 0; j < 8; ++j) { v[j] = xr[64 * j]; s += (v[j].x * v[j].x + v[j].y * v[j].y) + (v[j].z * v[j].z + v[j].w * v[j].w); }
    s = wave_sum(s);
    if (lane < 32) part[lane] = lane == 0 ? s : 0.f;
    u32x2* o8 = (u32x2*)orow + lane;
#pragma unroll
    for (int j = 0; j < 8; ++j) { u32x2 o; o.x = cvt_pk_bf16(v[j].x, v[j].y); o.y = cvt_pk_bf16(v[j].z, v[j].w); o8[64 * j] = o; }
}
__device__ __forceinline__ void norm_row_from_bf16(const bf16_t* xrow, const float* w, float* orow, int lane) {
    const u32x2* xr = (const u32x2*)xrow + lane; const f32x4* wr = (const f32x4*)w + lane;
    f32x4 v[8]; float s = 0.f;
#pragma unroll
    for (int j = 0; j < 8; ++j) { const u32x2 r = xr[64 * j]; v[j] = (f32x4){bflo(r.x), bfhi(r.x), bflo(r.y), bfhi(r.y)}; s += (v[j].x * v[j].x + v[j].y * v[j].y) + (v[j].z * v[j].z + v[j].w * v[j].w); }
    const float rstd = rsqrtf(wave_sum(s) * (1.f / 2048.f) + EPS);
    f32x4* o = (f32x4*)orow + lane;
#pragma unroll
    for (int j = 0; j < 8; ++j) { const f32x4 ww = wr[64 * j]; o[64 * j] = v[j] * rstd * ww; }
}
__device__ __forceinline__ void norm_row_f32(const float* xrow, const float* w, float* orow, int lane, float addc) {
    const f32x4* xr = (const f32x4*)xrow + lane; const f32x4* wr = (const f32x4*)w + lane;
    f32x4 v[8]; float s = 0.f;
#pragma unroll
    for (int j = 0; j < 8; ++j) { v[j] = xr[64 * j]; s += (v[j].x * v[j].x + v[j].y * v[j].y) + (v[j].z * v[j].z + v[j].w * v[j].w); }
    const float rstd = rsqrtf(wave_sum(s) * (1.f / 2048.f) + EPS);
    f32x4* o = (f32x4*)orow + lane;
#pragma unroll
    for (int j = 0; j < 8; ++j) { const f32x4 ww = wr[64 * j]; o[64 * j] = v[j] * rstd * ww + addc; }
}

constexpr int LP = 272;
__device__ __forceinline__ void conv8(const bf16_t* P, int tok, int col, int ch, const float* cw, const float* cb, float (&o)[8]) {
    const f32x4 b0 = *(const f32x4*)(cb + ch), b1 = *(const f32x4*)(cb + ch + 4);
    float a[8] = {b0[0], b0[1], b0[2], b0[3], b1[0], b1[1], b1[2], b1[3]};
#pragma unroll
    for (int k = 0; k < 4; ++k) { const int r = tok - 3 + k;
        if (r >= 0) { const u32x4 raw = *(const u32x4*)(P + (size_t)r * PW + col);
            const f32x4 w0 = *(const f32x4*)(cw + k * 4096 + ch), w1 = *(const f32x4*)(cw + k * 4096 + ch + 4);
            a[0] += bflo(raw.x) * w0[0]; a[1] += bfhi(raw.x) * w0[1]; a[2] += bflo(raw.y) * w0[2]; a[3] += bfhi(raw.y) * w0[3];
            a[4] += bflo(raw.z) * w1[0]; a[5] += bfhi(raw.z) * w1[1]; a[6] += bflo(raw.w) * w1[2]; a[7] += bfhi(raw.w) * w1[3]; } }
#pragma unroll
    for (int i = 0; i < 8; ++i) o[i] = silu_f(a[i]);
}
__device__ __forceinline__ float softplus_f(float x) { return x > 20.f ? x : log1pf(expf(x)); }
__device__ __forceinline__ void dt_cum(const float* dtraw, int tok0, int h, const float* dt_bias, const float* a_log, LAS float* dtv, LAS float* cum, int lane) {
    const float bias = dt_bias[h], a = -expf(a_log[h]);
    const int l0 = 2 * lane;
    const float d0 = softplus_f(dtraw[(size_t)(tok0 + l0) * 32 + h] + bias), d1 = softplus_f(dtraw[(size_t)(tok0 + l0 + 1) * 32 + h] + bias);
    const float s0 = d0 * a, s1 = s0 + d1 * a;
    float incl = s1;
#pragma unroll
    for (int o = 1; o < 64; o <<= 1) { const float t = __shfl_up(incl, o); if (lane >= o) incl += t; }
    const float excl = incl - s1;
    cum[l0] = excl + s0; cum[l0 + 1] = incl; dtv[l0] = d0; dtv[l0 + 1] = d1;
}

#define XB_TMO      128
#define XB_XCNT(j)  (256  + 64 * (j))
#define XB_XSUB(j)  (1280 + 64 * (j))
#define XB_XGEN(j)  (2304 + 64 * (j))
#define XB_TOP      3328
#define XB_TOPGEN   3392
#define XCD_BAR_WORDS 3456
#define XB_SPIN_CAP (1u << 22)
__device__ __forceinline__ unsigned xb_ld(unsigned* p)              { return __hip_atomic_load(p, __ATOMIC_RELAXED, __HIP_MEMORY_SCOPE_AGENT); }
__device__ __forceinline__ unsigned xb_add(unsigned* p, unsigned v) { return __hip_atomic_fetch_add(p, v, __ATOMIC_RELAXED, __HIP_MEMORY_SCOPE_AGENT); }
__device__ __forceinline__ unsigned xb_xcc_id() { return (unsigned)__builtin_amdgcn_s_getreg((3 << 11) | 20) & 0xFu; }
#define XB_SPIN(cond, bar) do { unsigned _sp = 0; while (cond) { __builtin_amdgcn_s_sleep(1); \
    if ((++_sp & 255u) == 0u) { if (xb_ld(&(bar)[XB_TMO])) break; if (_sp > XB_SPIN_CAP) { atomicAdd(&(bar)[XB_TMO], 1u); break; } } } } while (0)
struct XcdBarrier { unsigned* bar; unsigned x; volatile LAS unsigned* st; };
__device__ __forceinline__ XcdBarrier xcd_barrier_post(unsigned* bar, volatile LAS unsigned* st) {
    XcdBarrier b; b.bar = bar; b.x = xb_xcc_id(); b.st = st;
    if (threadIdx.x == 0) (void)xb_add(&bar[XB_XCNT(b.x)], 1u);
    return b;
}
__device__ __forceinline__ void xcd_barrier_complete(unsigned* bar, unsigned x, unsigned& nloc, unsigned& nx) {
    const unsigned G = gridDim.x * gridDim.y * gridDim.z;
    unsigned sum, cnt, mine, sp = 0u;
    for (;;) {
        sum = 0u; cnt = 0u; mine = 0u;
#pragma unroll
        for (unsigned j = 0; j < 16; ++j) { const unsigned c = xb_ld(&bar[XB_XCNT(j)]); sum += c; cnt += (c > 0u) ? 1u : 0u; mine = (j == x) ? c : mine; }
        if (sum == G) break;
        __builtin_amdgcn_s_sleep(1);
        if ((++sp & 255u) == 0u) { if (xb_ld(&bar[XB_TMO])) break; if (sp > XB_SPIN_CAP) { atomicAdd(&bar[XB_TMO], 1u); break; } }
    }
    nloc = mine > 0u ? mine : 1u; nx = cnt > 0u ? cnt : 1u;
}
__device__ __forceinline__ void xcd_barrier(const XcdBarrier& b) {
    asm volatile("s_waitcnt vmcnt(0)" ::: "memory");
    __syncthreads();
    if (threadIdx.x == 0) {
        unsigned* bar = b.bar;
        __builtin_amdgcn_s_waitcnt(0);
        unsigned nloc = b.st[0], nx = b.st[1];
        if (nloc == 0u) { xcd_barrier_complete(bar, b.x, nloc, nx); b.st[0] = nloc; b.st[1] = nx; }
        const unsigned old = xb_add(&bar[XB_XSUB(b.x)], 1u);
        const unsigned gen = old / nloc;
        if (old + 1u == (gen + 1u) * nloc) {
            __builtin_amdgcn_fence(__ATOMIC_RELEASE, "agent");
            asm volatile("s_waitcnt vmcnt(0)" ::: "memory");
            const unsigned og = xb_add(&bar[XB_TOP], 1u);
            const unsigned tg = og / nx;
            if (og + 1u == (tg + 1u) * nx) xb_add(&bar[XB_TOPGEN], 1u);
            else XB_SPIN(xb_ld(&bar[XB_TOPGEN]) == tg, bar);
            __builtin_amdgcn_fence(__ATOMIC_ACQUIRE, "agent");
            xb_add(&bar[XB_XGEN(b.x)], 1u);
            asm volatile("s_waitcnt vmcnt(0)" ::: "memory");
        } else {
            XB_SPIN(xb_ld(&bar[XB_XGEN(b.x)]) == gen, bar);
            __builtin_amdgcn_fence(__ATOMIC_ACQUIRE, "agent");
            asm volatile("s_waitcnt vmcnt(0)" ::: "memory");
        }
    }
    __syncthreads();
}

#define CG_SYNC() do { asm volatile("s_waitcnt vmcnt(0) lgkmcnt(0)" ::: "memory"); __syncthreads(); grid.sync(); __builtin_amdgcn_fence(__ATOMIC_ACQUIRE, "agent"); asm volatile("s_waitcnt vmcnt(0)" ::: "memory"); __syncthreads(); } while (0)
#define GRID_SYNC() for (int rs_ = 0; rs_ < REP_SYNC; ++rs_) xcd_barrier(xbar)
__device__ __forceinline__ void dt_cum_r(float r0, float r1, int h, const float* dt_bias, const float* a_log, LAS float* dtv, LAS float* cum, int lane) {
    const float bias = dt_bias[h], a = -expf(a_log[h]);
    const int l0 = 2 * lane;
    const float d0 = softplus_f(r0 + bias), d1 = softplus_f(r1 + bias);
    const float s0 = d0 * a, s1 = s0 + d1 * a;
    float incl = s1;
#pragma unroll
    for (int o = 1; o < 64; o <<= 1) { const float t = __shfl_up(incl, o); if (lane >= o) incl += t; }
    const float excl = incl - s1;
    cum[l0] = excl + s0; cum[l0 + 1] = incl; dtv[l0] = d0; dtv[l0 + 1] = d1;
}
#define SCATTER8(dst, raw) do { \
    *(LAS unsigned short*)((dst) + 0 * LP) = (unsigned short)((raw).x & 0xffffu); *(LAS unsigned short*)((dst) + 1 * LP) = (unsigned short)((raw).x >> 16); \
    *(LAS unsigned short*)((dst) + 2 * LP) = (unsigned short)((raw).y & 0xffffu); *(LAS unsigned short*)((dst) + 3 * LP) = (unsigned short)((raw).y >> 16); \
    *(LAS unsigned short*)((dst) + 4 * LP) = (unsigned short)((raw).z & 0xffffu); *(LAS unsigned short*)((dst) + 5 * LP) = (unsigned short)((raw).z >> 16); \
    *(LAS unsigned short*)((dst) + 6 * LP) = (unsigned short)((raw).w & 0xffffu); *(LAS unsigned short*)((dst) + 7 * LP) = (unsigned short)((raw).w >> 16); } while (0)
#define MFMA16(a, b, c) __builtin_amdgcn_mfma_f32_16x16x32_bf16((a), (b), (c), 0, 0, 0)

__global__ void __launch_bounds__(512, 2) mega_fwd(Args args) {
    extern __shared__ __attribute__((aligned(16))) unsigned char lds_raw[];
    LAS unsigned char* lds = (LAS unsigned char*)lds_raw;
    cg::grid_group grid = cg::this_grid();
    const int G = gridDim.x, bid = blockIdx.x;
#define PHASE_IDS const CAS gfptr* inp = (const CAS gfptr*)__builtin_amdgcn_kernarg_segment_ptr(); asm volatile("" : "+s"(inp)); (void)inp; int tid = threadIdx.x; asm volatile("" : "+v"(tid)); const int lane = tid & 63, wave = __builtin_amdgcn_readfirstlane(tid >> 6); \
    const int gw = bid * 8 + wave, NGW = G * 8; const int fr = lane & 15, fq = lane >> 4; (void)gw; (void)NGW; (void)fr; (void)fq; (void)lane;
    unsigned char* ws = args.ws;
    volatile LAS unsigned* MISC = (volatile LAS unsigned*)(lds + LDS_BYTES - 128);
    if (threadIdx.x < 32) MISC[threadIdx.x] = 0u;
    __syncthreads();
    const XcdBarrier xbar = xcd_barrier_post((unsigned*)ws, MISC + 8);
    unsigned long long pa0 = 0, pa1 = 0, pb0 = 0, pb1 = 0;
#define STAMP(k) do { if (PROBE_A >= 0) { const unsigned long long t_ = __builtin_amdgcn_s_memrealtime(); if ((k) == PROBE_A) pa0 = t_; if ((k) == PROBE_A + 1) pa1 = t_; if ((k) == PROBE_B) pb0 = t_; if ((k) == PROBE_B + 1) pb1 = t_; } } while (0)
    STAMP(0);
    bf16_t* HB = (bf16_t*)(ws + WS_WGU1);
    bf16_t* WGU1 = (bf16_t*)(ws + WS_WGU1); bf16_t* WD1 = (bf16_t*)(ws + WS_WD1); bf16_t* WIN = (bf16_t*)(ws + WS_WIN);
    bf16_t* WOUTA = (bf16_t*)(ws + WS_WOUTA); bf16_t* WOUTM = (bf16_t*)(ws + WS_WOUTM); bf16_t* WQ = (bf16_t*)(ws + WS_WQ);
    bf16_t* WKV = (bf16_t*)(ws + WS_WKV); bf16_t* WO = (bf16_t*)(ws + WS_WO); bf16_t* WGU2 = (bf16_t*)(ws + WS_WGU2); bf16_t* WD2 = (bf16_t*)(ws + WS_WD2);
    bf16_t* XN = (bf16_t*)(ws + WS_XN); bf16_t* P = (bf16_t*)(ws + WS_P); bf16_t* ACT = (bf16_t*)(ws + WS_ACT); bf16_t* ACT2 = (bf16_t*)(ws + WS_ACT2);
    bf16_t* QB = (bf16_t*)(ws + WS_Q); bf16_t* OB = (bf16_t*)(ws + WS_O);
    float* ST = (float*)(ws + WS_ST); float* DT = (float*)(ws + WS_DT); float* VPART = (float*)(ws + WS_VPART); float* YPART = (float*)(ws + WS_YPART);
    float* NPA = (float*)(ws + WS_NPA); float* NPB = (float*)(ws + WS_NPB); float* NPC = (float*)(ws + WS_NPC); float* NPD = (float*)(ws + WS_NPD);
    bf16_t* HALO = (bf16_t*)(ws + WS_HALO);
    float* CDEC = (float*)(ws + WS_CDEC); bf16_t* KB = (bf16_t*)(ws + WS_KB); bf16_t* VT = (bf16_t*)(ws + WS_VT); bf16_t* MEMN = (bf16_t*)(ws + WS_MEMN);

    constexpr int I_GU = 32 * 352, I_DN = 88 * 64, I_WIN = 32 * 321, I_SQ = 32 * 64, I_KV = 32 * 128;
    constexpr int CV_P0_END = I_GU + I_KV, CV_P1_END = I_GU + I_KV + I_WIN + I_DN, CV_END = 2 * I_GU + 2 * I_DN + I_WIN + 4 * I_SQ + I_KV, CV_P4_END = CV_END - I_DN;
#define CONVERT_RANGE(lo, hi, rank, nwork) do { LAS float* scr_ = (LAS float*)(lds + wave * 16384); \
        for (int it_ = (lo) + (rank) * 8 + wave; it_ < (hi); it_ += (nwork) * 8) { int r_ = it_; \
            if (r_ < I_GU) { tr_item(((const float*)inp[3]), DM, 2 * DFF, WGU1, 1, scr_, r_, lane, ((const float*)inp[2])); continue; } r_ -= I_GU; \
            if (r_ < I_KV) { tr_item(((const float*)inp[20]), DM, 2 * DM, WKV, 0, scr_, r_, lane); continue; } r_ -= I_KV; \
            if (r_ < I_WIN) { tr_item(((const float*)inp[6]), DM, 10272, WIN, 2, scr_, r_, lane, ((const float*)inp[5])); continue; } r_ -= I_WIN; \
            if (r_ < I_DN) { tr_item(((const float*)inp[4]), DFF, DM, WD1, 0, scr_, r_, lane); continue; } r_ -= I_DN; \
            if (r_ < 2 * I_SQ) { tr_item(((const float*)inp[16]), 2 * DM, DM, WOUTA, 3, scr_, r_, lane); continue; } r_ -= 2 * I_SQ; \
            if (r_ < I_SQ) { tr_item(((const float*)inp[19]), DM, DM, WQ, 0, scr_, r_, lane, ((const float*)inp[17])); continue; } r_ -= I_SQ; \
            if (r_ < I_SQ) { tr_item(((const float*)inp[21]), DM, DM, WO, 0, scr_, r_, lane); continue; } r_ -= I_SQ; \
            if (r_ < I_GU) { tr_item(((const float*)inp[23]), DM, 2 * DFF, WGU2, 1, scr_, r_, lane, ((const float*)inp[22])); continue; } r_ -= I_GU; \
            tr_item(((const float*)inp[24]), DFF, DM, WD2, 0, scr_, r_, lane); } } while (0)

    { PHASE_IDS
        CONVERT_RANGE(0, CV_P0_END, bid, G);
        for (int m = gw; m < SEQ + MEML; m += NGW) {
            if (m < SEQ) wrow_bf16(((const float*)inp[0]) + (size_t)m * DM, XN + (size_t)m * DM, NPD + (size_t)m * 32, lane);
            else norm_row_bf16(((const float*)inp[1]) + (size_t)(m - SEQ) * DM, ((const float*)inp[18]), MEMN + (size_t)(m - SEQ) * DM, lane);
        }
    }
    if (args.out == nullptr) CG_SYNC();
    GRID_SYNC(); STAMP(1);

    {
        pg8::Gemm g{XN, WGU1, SEQ, 2 * DFF, DM, DM}; pg8::StaticOrder S; S.init(SEQ, 2 * DFF, G, bid);
        LAS float* rsl = (LAS float*)(lds + 131072); prep_rstd(S, NPD, rsl);
        pg8::EpiSwiGLU E{ACT, DFF, rsl};
        pg8::gemm_phase<pg8::EpiSwiGLU, pg8::StaticOrder, true>(lds, g, S, E);
        pg8::Gemm g2{MEMN, WKV, MEML, 2 * DM, DM, DM}; pg8::StaticOrder S2; S2.init(MEML, 2 * DM, G, (bid + G - (G / 2)) % G);
        pg8::EpiKV E2{KB, VT};
        pg8::gemm_phase<pg8::EpiKV, pg8::StaticOrder, true>(lds, g2, S2, E2);
        { PHASE_IDS
            const int ntile = 32 * 44, full = (ntile + G - 1) / G, istart = ntile - (full - 1) * G + 16; const bool all = istart >= G;
            __syncthreads();
            if (all || bid >= istart) CONVERT_RANGE(CV_P0_END, CV_P1_END, (all ? bid : bid - istart), (all ? G : G - istart)); }
    }
    GRID_SYNC(); STAMP(2);

    {
        pg8::Gemm g{ACT, WD1, SEQ, DM, DFF, DFF}; pg8::StaticOrder S; S.init(SEQ, DM, G, bid); S.rep = REPG_P2;
        const CAS gfptr* inp = (const CAS gfptr*)__builtin_amdgcn_kernarg_segment_ptr();
        pg8::EpiResid<false> E{XN, HB, DM, 0.5f, nullptr, nullptr, nullptr, NPA};
        pg8::gemm_phase<pg8::EpiResid<false>, pg8::StaticOrder, true>(lds, g, S, E);
    }
    GRID_SYNC(); STAMP(3);


    {
        pg8::Gemm g{HB, WIN, SEQ, 41 * 256, DM, DM}; pg8::StaticOrder S; S.init(SEQ, 41 * 256, G, bid); S.rep = REPG_P4;
        LAS float* rsl = (LAS float*)(lds + 131072); prep_rstd(S, NPA, rsl);
        pg8::EpiWin E{P, DT, VPART, rsl, HALO};
        pg8::gemm_phase<pg8::EpiWin, pg8::StaticOrder, true>(lds, g, S, E);
        { PHASE_IDS
            const int ntile = 32 * 41, full = (ntile + G - 1) / G, istart = ntile - (full - 1) * G; const bool all = istart >= G;
            __syncthreads();
            if (all || bid >= istart) CONVERT_RANGE(CV_P1_END, CV_P4_END, (all ? bid : bid - istart), (all ? G : G - istart)); }
    }
    GRID_SYNC(); STAMP(5);

    { PHASE_IDS
        const float* cw = ((const float*)inp[10]); const float* cb = ((const float*)inp[11]);
        const int ch = tid * 8;
        for (int rb = bid; rb < SEQ / 32; rb += G) {
            f32x4 w0[4], w1[4];
#pragma unroll
            for (int k = 0; k < 4; ++k) { w0[k] = *(const f32x4*)(cw + k * 4096 + ch); w1[k] = *(const f32x4*)(cw + k * 4096 + ch + 4); }
            const f32x4 b0 = *(const f32x4*)(cb + ch), b1 = *(const f32x4*)(cb + ch + 4);
            f32x4 xa[3], xb[3];
#pragma unroll
            for (int k = 0; k < 3; ++k) { u32x4 raw = {0u, 0u, 0u, 0u}; if (rb > 0) raw = *(const u32x4*)(HALO + ((size_t)(rb - 1) * 3 + k) * 4096 + ch);
                xa[k] = (f32x4){bflo(raw.x), bfhi(raw.x), bflo(raw.y), bfhi(raw.y)}; xb[k] = (f32x4){bflo(raw.z), bfhi(raw.z), bflo(raw.w), bfhi(raw.w)}; }
            bf16_t* pp = P + (size_t)(rb * 32) * PW + PX0 + ch;
#pragma unroll 8
            for (int r = 0; r < 32; ++r) { const u32x4 raw = *(const u32x4*)(pp + (size_t)r * PW);
                const f32x4 ca = {bflo(raw.x), bfhi(raw.x), bflo(raw.y), bfhi(raw.y)}, cbv = {bflo(raw.z), bfhi(raw.z), bflo(raw.w), bfhi(raw.w)};
                const f32x4 ya = b0 + w0[0] * xa[0] + w0[1] * xa[1] + w0[2] * xa[2] + w0[3] * ca, yb = b1 + w1[0] * xb[0] + w1[1] * xb[1] + w1[2] * xb[2] + w1[3] * cbv;
                u32x4 o; o.x = cvt_pk_bf16(silu_f(ya[0]), silu_f(ya[1])); o.y = cvt_pk_bf16(silu_f(ya[2]), silu_f(ya[3])); o.z = cvt_pk_bf16(silu_f(yb[0]), silu_f(yb[1])); o.w = cvt_pk_bf16(silu_f(yb[2]), silu_f(yb[3]));
                *(u32x4*)(pp + (size_t)r * PW) = o;
                xa[0] = xa[1]; xa[1] = xa[2]; xa[2] = ca; xb[0] = xb[1]; xb[1] = xb[2]; xb[2] = cbv; }
        }
    }
    { PHASE_IDS
        constexpr int GV0_OFF = 0, GV1_OFF = 128 * LP, AM_OFF = 2 * 128 * LP, RS_OFF = 3 * 128 * LP;
        LAS float* rs = (LAS float*)(lds + RS_OFF);
        const float* w_s = ((const float*)inp[8]); const float* b_s = ((const float*)inp[9]); const float* vnw = ((const float*)inp[7]);
        for (int unit = bid; unit < 64 * 4; unit += G) {
            const int c = unit >> 2, g = unit & 3, tok0 = c * 128;
            u32x4 rg[4];
#define GV_LOAD(DQ) do { _Pragma("unroll") for (int k = 0; k < 4; ++k) rg[k] = *(const u32x4*)(P + (size_t)(tok0 + (tid >> 4) + 32 * k) * PW + PV0 + g * 512 + (DQ) * 128 + (tid & 15) * 8); } while (0)
#define GV_SCATTER(BUF) do { _Pragma("unroll") for (int k = 0; k < 4; ++k) { LAS unsigned char* dst = lds + (BUF) + ((tid & 15) * 8) * LP + ((tid >> 4) + 32 * k) * 2; SCATTER8(dst, rg[k]); } } while (0)
            GV_LOAD(0);
            __syncthreads();
            if (tid < 128) { const f32x4* pp = (const f32x4*)(VPART + (size_t)(tok0 + tid) * 32); float sm = 0.f;
#pragma unroll
                for (int q = 0; q < 8; ++q) { const f32x4 t = pp[q]; sm += (t[0] + t[1]) + (t[2] + t[3]); }
                rs[tid] = rsqrtf(sm * (1.f / 2048.f) + EPS); }
            __syncthreads();
#pragma unroll
            for (int k = 0; k < 4; ++k) { const int t = (tid >> 4) + 32 * k, s8 = (tid & 15) * 8;
                const f32x4 w0 = *(const f32x4*)(w_s + ((size_t)g * 128 + t) * 128 + s8), w1 = *(const f32x4*)(w_s + ((size_t)g * 128 + t) * 128 + s8 + 4);
                float v[8] = {w0[0], w0[1], w0[2], w0[3], w1[0], w1[1], w1[2], w1[3]};
#pragma unroll
                for (int q = 0; q < 8; ++q) v[q] = (s8 + q <= t) ? v[q] * rs[s8 + q] : 0.f;
                *(LAS bf16x8*)(lds + AM_OFF + t * LP + s8 * 2) = pack8(v); }
            GV_SCATTER(GV0_OFF);
            GV_LOAD(1);
            __syncthreads();
#pragma unroll
            for (int dq = 0; dq < 4; ++dq) {
                const int gvb = (dq & 1) ? GV1_OFF : GV0_OFF, ch0 = g * 512 + dq * 128;
                u32x2 uu[8];
#pragma unroll
                for (int tt = 0; tt < 8; ++tt) uu[tt] = *(const u32x2*)(P + (size_t)(tok0 + tt * 16 + fr) * PW + PU0 + ch0 + 16 * wave + fq * 4);
                bf16x8 afr[4];
#pragma unroll
                for (int kk = 0; kk < 4; ++kk) afr[kk] = *(LAS bf16x8*)(lds + gvb + (16 * wave + fr) * LP + (kk * 32 + fq * 8) * 2);
                const f32x4 wv = *(const f32x4*)(vnw + ch0 + 16 * wave + fq * 4);
#pragma unroll
                for (int tt = 0; tt < 8; ++tt) { f32x4 acc = {0.f, 0.f, 0.f, 0.f};
#pragma unroll
                    for (int kk = 0; kk < 4; ++kk) { const bf16x8 bq = *(LAS bf16x8*)(lds + AM_OFF + (tt * 16 + fr) * LP + (kk * 32 + fq * 8) * 2); acc = MFMA16(afr[kk], bq, acc); }
                    const int t = tt * 16 + fr; const float bb = b_s[g * 128 + t];
                    bf16_t* up = P + (size_t)(tok0 + t) * PW + PU0 + ch0 + 16 * wave + fq * 4;
                    u32x2 o; o.x = cvt_pk_bf16(bflo(uu[tt].x) * (acc[0] * wv[0] + bb), bfhi(uu[tt].x) * (acc[1] * wv[1] + bb)); o.y = cvt_pk_bf16(bflo(uu[tt].y) * (acc[2] * wv[2] + bb), bfhi(uu[tt].y) * (acc[3] * wv[3] + bb));
                    *(u32x2*)up = o; }
                if (dq < 3) { GV_SCATTER((dq & 1) ? GV0_OFF : GV1_OFF); if (dq < 2) GV_LOAD(dq + 2); __syncthreads(); }
            }
#undef GV_LOAD
#undef GV_SCATTER
        }
    }
    GRID_SYNC(); STAMP(4);

    { PHASE_IDS
        constexpr int XT_OFF = 0, BP_OFF = 64 * LP, SC_OFF = BP_OFF + 128 * LP;
        LAS float* dtv = (LAS float*)(lds + SC_OFF); LAS float* cum = dtv + 128;
        const float* dtb = ((const float*)inp[12]); const float* alog = ((const float*)inp[13]);
        constexpr int NU = REPU_P5A * 64 * NHEAD;
        u32x4 rx[2], rb[4]; float rd0 = 0.f, rd1 = 0.f;
#define P5A_LOAD(UU) do { const int un_ = (UU) % (64 * NHEAD); const int h_ = un_ & 31, g_ = h_ >> 2, t_ = (un_ >> 5) * 128; \
            _Pragma("unroll") for (int k = 0; k < 2; ++k) rx[k] = *(const u32x4*)(P + (size_t)(t_ + (tid >> 3) + 64 * k) * PW + PX0 + h_ * 64 + (tid & 7) * 8); \
            _Pragma("unroll") for (int k = 0; k < 4; ++k) rb[k] = *(const u32x4*)(P + (size_t)(t_ + (tid >> 4) + 32 * k) * PW + PX0 + 2048 + g_ * 128 + (tid & 15) * 8); \
            rd0 = DT[(size_t)(t_ + 2 * lane) * 32 + h_]; rd1 = DT[(size_t)(t_ + 2 * lane + 1) * 32 + h_]; } while (0)
        int uu = bid;
        if (uu < NU) P5A_LOAD(uu);
        for (; uu < NU; uu += G) { const int unit = uu % (64 * NHEAD);
            const int c = unit >> 5, h = unit & 31;
            __syncthreads();
            if (wave == 0) dt_cum_r(rd0, rd1, h, dtb, alog, dtv, cum, lane);
#pragma unroll
            for (int k = 0; k < 2; ++k) { LAS unsigned char* dst = lds + XT_OFF + ((tid & 7) * 8) * LP + ((tid >> 3) + 64 * k) * 2; SCATTER8(dst, rx[k]); }
#pragma unroll
            for (int k = 0; k < 4; ++k) *(LAS u32x4*)(lds + BP_OFF + ((tid >> 4) + 32 * k) * LP + (tid & 15) * 16) = rb[k];
            if (uu + G < NU) P5A_LOAD(uu + G);
            __syncthreads();
            const float cl = cum[127];
            if (tid == 0) CDEC[c * 32 + h] = expf(cl);
            bf16x8 bfr[4];
#pragma unroll
            for (int kk = 0; kk < 4; ++kk) { bf16x8 t;
#pragma unroll
                for (int j = 0; j < 8; ++j) t[j] = (short)*(LAS unsigned short*)(lds + BP_OFF + (kk * 32 + fq * 8 + j) * LP + (16 * wave + fr) * 2);
                bfr[kk] = t; }
            float wl[4][8];
#pragma unroll
            for (int kk = 0; kk < 4; ++kk)
#pragma unroll
                for (int j = 0; j < 8; ++j) { const int l = kk * 32 + fq * 8 + j; wl[kk][j] = dtv[l] * __expf(cl - cum[l]); }
            float* stp = ST + ((size_t)(c * 32 + h) * 64) * 128;
#pragma unroll
            for (int pt = 0; pt < 4; ++pt) { f32x4 acc = {0.f, 0.f, 0.f, 0.f};
#pragma unroll
                for (int kk = 0; kk < 4; ++kk) { const bf16x8 raw = *(LAS bf16x8*)(lds + XT_OFF + (pt * 16 + fr) * LP + (kk * 32 + fq * 8) * 2); float v[8];
#pragma unroll
                    for (int j = 0; j < 8; ++j) v[j] = bf2f((unsigned short)raw[j]) * wl[kk][j];
                    acc = MFMA16(bfr[kk], pack8(v), acc); }
                *(f32x4*)(stp + (size_t)(pt * 16 + fr) * 128 + 16 * wave + fq * 4) = acc; }
        }
#undef P5A_LOAD
    }
    GRID_SYNC(); STAMP(6);

    { PHASE_IDS
        for (int e = bid * 512 + tid; e < NHEAD * 64 * 128 / 2; e += G * 512) {
            const int h = e / (64 * 128 / 2);
            f32x2 carry = {0.f, 0.f};
            f32x2* p = (f32x2*)ST + e;
#pragma unroll 8
            for (int c = 0; c < 64; ++c) { const f32x2 v = p[(size_t)c * (NHEAD * 64 * 128 / 2)]; const float d = CDEC[c * 32 + h]; p[(size_t)c * (NHEAD * 64 * 128 / 2)] = carry; carry = carry * d + v; }
        }
    }
    GRID_SYNC(); STAMP(7);

    { PHASE_IDS
        constexpr int XT_OFF = 0, BP_OFF = 64 * LP, CP_OFF = BP_OFF + 128 * LP, MM_OFF = CP_OFF + 128 * LP, SC_OFF = MM_OFF + 128 * LP, PV_OFF = SC_OFF + 1024;
        static_assert(PV_OFF + 64 * LP <= LDS_BYTES - 128, "P7 LDS map");
        LAS float* dtv = (LAS float*)(lds + SC_OFF); LAS float* cum = dtv + 128;
        const float* dskip = ((const float*)inp[14]); const float* snw = ((const float*)inp[15]);
        const float* dtb = ((const float*)inp[12]); const float* alog = ((const float*)inp[13]);
        constexpr int NU = 64 * 8;
        u32x4 rx[2], rbc[8]; f32x4 rp[4]; float rd0 = 0.f, rd1 = 0.f;
        const int bccol = ((tid & 31) < 16) ? (tid & 31) * 8 : 1024 + ((tid & 31) - 16) * 8;
#define P7_BC_LOAD(UN) do { const int g_ = (UN) & 7, t_ = ((UN) >> 3) * 128; \
            _Pragma("unroll") for (int k = 0; k < 8; ++k) rbc[k] = *(const u32x4*)(P + (size_t)(t_ + (tid >> 5) + 16 * k) * PW + PX0 + 2048 + g_ * 128 + bccol); } while (0)
#define P7_H_LOAD(UN, R) do { const int h_ = ((UN) & 7) * 4 + (R), c_ = (UN) >> 3, t_ = c_ * 128; \
            _Pragma("unroll") for (int k = 0; k < 2; ++k) rx[k] = *(const u32x4*)(P + (size_t)(t_ + (tid >> 3) + 64 * k) * PW + PX0 + h_ * 64 + (tid & 7) * 8); \
            _Pragma("unroll") for (int k = 0; k < 4; ++k) rp[k] = ((const f32x4*)(ST + (size_t)(c_ * 32 + h_) * 64 * 128))[tid + 512 * k]; \
            rd0 = DT[(size_t)(t_ + 2 * lane) * 32 + h_]; rd1 = DT[(size_t)(t_ + 2 * lane + 1) * 32 + h_]; } while (0)
#define P7_H_STAGE(H) do { if (wave == 0) dt_cum_r(rd0, rd1, (H), dtb, alog, dtv, cum, lane); \
            _Pragma("unroll") for (int k = 0; k < 2; ++k) { LAS unsigned char* dst = lds + XT_OFF + ((tid & 7) * 8) * LP + ((tid >> 3) + 64 * k) * 2; SCATTER8(dst, rx[k]); } \
            _Pragma("unroll") for (int k = 0; k < 4; ++k) { u32x2 o; o.x = cvt_pk_bf16(rp[k][0], rp[k][1]); o.y = cvt_pk_bf16(rp[k][2], rp[k][3]); \
                *(LAS u32x2*)(lds + PV_OFF + ((tid >> 5) + 16 * k) * LP + (tid & 31) * 8) = o; } } while (0)
        for (int unit = bid; unit < NU; unit += G) {
            const int c = unit >> 3, g = unit & 7, tok0 = c * 128;
            P7_BC_LOAD(unit); P7_H_LOAD(unit, 0);
            __syncthreads();
#pragma unroll
            for (int k = 0; k < 8; ++k) *(LAS u32x4*)(lds + ((tid & 31) < 16 ? BP_OFF + (tid & 31) * 16 : CP_OFF + ((tid & 31) - 16) * 16) + ((tid >> 5) + 16 * k) * LP) = rbc[k];
            P7_H_STAGE(4 * g);
            P7_H_LOAD(unit, 1);
            __syncthreads();
            bf16x8 cfr[4];
#pragma unroll
            for (int kk = 0; kk < 4; ++kk) cfr[kk] = *(LAS bf16x8*)(lds + CP_OFF + (16 * wave + fr) * LP + (kk * 32 + fq * 8) * 2);
            const int l = 16 * wave + fr; const int tok = tok0 + l;
            f32x4 sacc[8];
#pragma unroll
            for (int st = 0; st < 8; ++st) { f32x4 acc = {0.f, 0.f, 0.f, 0.f};
#pragma unroll
                for (int kk = 0; kk < 4; ++kk) { const bf16x8 a = *(LAS bf16x8*)(lds + BP_OFF + (st * 16 + fr) * LP + (kk * 32 + fq * 8) * 2); acc = MFMA16(a, cfr[kk], acc); }
                sacc[st] = acc; }
#pragma unroll
            for (int r = 0; r < 4; ++r) { const int h = 4 * g + r;
                if (r > 0) { __syncthreads(); P7_H_STAGE(h);
                    if (r < 3) P7_H_LOAD(unit, r + 1);
                    __syncthreads(); }
                const float cl = cum[l];
#pragma unroll
                for (int st = 0; st < 8; ++st) { float mv[4];
#pragma unroll
                    for (int j = 0; j < 4; ++j) { const int sx = st * 16 + fq * 4 + j; mv[j] = (sx <= l) ? sacc[st][j] * __expf(cl - cum[sx]) * dtv[sx] : 0.f; }
                    u32x2 o; o.x = cvt_pk_bf16(mv[0], mv[1]); o.y = cvt_pk_bf16(mv[2], mv[3]);
                    *(LAS u32x2*)(lds + MM_OFF + l * LP + (st * 16 + fq * 4) * 2) = o; }
                asm volatile("s_waitcnt lgkmcnt(0)" ::: "memory");
                bf16x8 mfr[4];
#pragma unroll
                for (int kk = 0; kk < 4; ++kk) mfr[kk] = *(LAS bf16x8*)(lds + MM_OFF + l * LP + (kk * 32 + fq * 8) * 2);
                const float ecl = __expf(cl), dsk = dskip[h];
                float ss = 0.f;
#pragma unroll
                for (int pt = 0; pt < 4; ++pt) { f32x4 ad = {0.f, 0.f, 0.f, 0.f}, ao = {0.f, 0.f, 0.f, 0.f};
#pragma unroll
                    for (int kk = 0; kk < 4; ++kk) { const bf16x8 a = *(LAS bf16x8*)(lds + XT_OFF + (pt * 16 + fr) * LP + (kk * 32 + fq * 8) * 2); ad = MFMA16(a, mfr[kk], ad);
                        const bf16x8 pa = *(LAS bf16x8*)(lds + PV_OFF + (pt * 16 + fr) * LP + (kk * 32 + fq * 8) * 2); ao = MFMA16(pa, cfr[kk], ao); }
                    const int p0i = pt * 16 + fq * 4;
                    bf16_t* zp = P + (size_t)tok * PW + PZ0 + h * 64 + p0i;
                    const u32x2 zz = *(const u32x2*)zp; const float zf[4] = {bflo(zz.x), bfhi(zz.x), bflo(zz.y), bfhi(zz.y)};
                    const f32x4 nw = *(const f32x4*)(snw + h * 64 + p0i);
                    float yv[4];
#pragma unroll
                    for (int j = 0; j < 4; ++j) { const float xv = bf2f(*(LAS unsigned short*)(lds + XT_OFF + (p0i + j) * LP + l * 2));
                        const float y = (ad[j] + ecl * ao[j] + dsk * xv) * zf[j]; ss += y * y; yv[j] = y * nw[j]; }
                    u32x2 o; o.x = cvt_pk_bf16(yv[0], yv[1]); o.y = cvt_pk_bf16(yv[2], yv[3]);
                    *(u32x2*)zp = o; }
                ss += __shfl_xor(ss, 16); ss += __shfl_xor(ss, 32);
                if (fq == 0) YPART[(size_t)tok * 32 + h] = ss;
            }
        }
#undef P7_BC_LOAD
#undef P7_H_LOAD
#undef P7_H_STAGE
    }
    GRID_SYNC(); STAMP(8);

    {
        pg8::StaticOrder S; S.init(SEQ, DM, G, bid);
        const CAS gfptr* inp = (const CAS gfptr*)__builtin_amdgcn_kernarg_segment_ptr();
        LAS float* rsl = (LAS float*)(lds + 131072); prep_rstd(S, YPART, rsl);
        pg8::Gemm g{P + PZ0, WOUTA, SEQ, DM, 2 * DM, PW, 32, (long)(PU0 - PZ0 - DM) * 2};
        pg8::EpiResidMid E; E.base = HB; E.out = HB; E.ldc = DM; E.alpha = 1.0f; E.part = nullptr; E.xn = nullptr; E.nw = nullptr; E.npart = NPB; E.rsl = rsl;
        pg8::gemm_phase<pg8::EpiResidMid, pg8::StaticOrder, true>(lds, g, S, E);
    }
    GRID_SYNC(); STAMP(9);


    {
        pg8::Gemm g{HB, WQ, SEQ, DM, DM, DM}; pg8::StaticOrder S; S.init(SEQ, DM, G, bid);
        LAS float* rsl = (LAS float*)(lds + 131072); prep_rstd(S, NPB, rsl);
        pg8::EpiBf16 E{QB, DM, 0.044194173824159216f, rsl};
        pg8::gemm_phase<pg8::EpiBf16, pg8::StaticOrder, true>(lds, g, S, E);
    }
    GRID_SYNC(); STAMP(11);

    { PHASE_IDS
        constexpr int KP = 272, VP = 528, PP = 528, PBUF = 69632;
        LAS unsigned char* pw = lds + PBUF + wave * 8448;
        for (int uu = bid; uu < REPU_P11 * 64 * 4; uu += G) { const int unit = uu % (64 * 4);
            const int tb = unit >> 2, h = unit & 3, t0 = tb * 128 + 16 * wave;
            __syncthreads();
            u32x4 stg[8];
#define LOADK(c) do { _Pragma("unroll") for (int i = 0; i < 8; ++i) stg[i] = *(const u32x4*)(KB + (size_t)((tid >> 4) + 32 * i) * DM + h * 512 + (c) * 128 + (tid & 15) * 8); } while (0)
#define STOREK() do { _Pragma("unroll") for (int i = 0; i < 8; ++i) *(LAS u32x4*)(lds + ((tid >> 4) + 32 * i) * KP + (tid & 15) * 16) = stg[i]; } while (0)
#define LOADV(v) do { _Pragma("unroll") for (int i = 0; i < 8; ++i) stg[i] = *(const u32x4*)(VT + (size_t)(h * 512 + (v) * 128 + (tid >> 5) + 16 * i) * 256 + (tid & 31) * 8); } while (0)
#define STOREV() do { _Pragma("unroll") for (int i = 0; i < 8; ++i) *(LAS u32x4*)(lds + ((tid >> 5) + 16 * i) * VP + (tid & 31) * 16) = stg[i]; } while (0)
            LOADK(0);
            bf16x8 qf[16];
#pragma unroll
            for (int kk = 0; kk < 16; ++kk) qf[kk] = *(const bf16x8*)(QB + (size_t)(t0 + fr) * DM + h * 512 + kk * 32 + fq * 8);
            STOREK();
            __syncthreads();
            f32x4 sacc[16];
#pragma unroll
            for (int mt = 0; mt < 16; ++mt) sacc[mt] = (f32x4){0.f, 0.f, 0.f, 0.f};
#pragma unroll
            for (int c = 0; c < 4; ++c) {
                if (c < 3) LOADK(c + 1); else LOADV(0);
#pragma unroll
                for (int mt = 0; mt < 16; ++mt)
#pragma unroll
                    for (int kk = 0; kk < 4; ++kk) { const bf16x8 a = *(LAS bf16x8*)(lds + (mt * 16 + fr) * KP + (kk * 32 + fq * 8) * 2); sacc[mt] = MFMA16(a, qf[c * 4 + kk], sacc[mt]); }
                __syncthreads();
                if (c < 3) STOREK(); else STOREV();
                __syncthreads();
            }
            float mx = -3.0e38f;
#pragma unroll
            for (int mt = 0; mt < 16; ++mt)
#pragma unroll
                for (int j = 0; j < 4; ++j) mx = fmaxf(mx, sacc[mt][j]);
            mx = fmaxf(mx, __shfl_xor(mx, 16)); mx = fmaxf(mx, __shfl_xor(mx, 32));
            float sum = 0.f;
#pragma unroll
            for (int mt = 0; mt < 16; ++mt)
#pragma unroll
                for (int j = 0; j < 4; ++j) { const float e = __expf(sacc[mt][j] - mx); sacc[mt][j] = e; sum += e; }
            sum += __shfl_xor(sum, 16); sum += __shfl_xor(sum, 32);
            const float inv = 1.0f / sum;
#pragma unroll
            for (int mt = 0; mt < 16; ++mt) { u32x2 o; o.x = cvt_pk_bf16(sacc[mt][0] * inv, sacc[mt][1] * inv); o.y = cvt_pk_bf16(sacc[mt][2] * inv, sacc[mt][3] * inv);
                *(LAS u32x2*)(pw + fr * PP + (mt * 16 + fq * 4) * 2) = o; }
            asm volatile("s_waitcnt lgkmcnt(0)" ::: "memory");
            bf16x8 pf[8];
#pragma unroll
            for (int kk = 0; kk < 8; ++kk) pf[kk] = *(LAS bf16x8*)(pw + fr * PP + (kk * 32 + fq * 8) * 2);
#pragma unroll
            for (int v = 0; v < 4; ++v) {
                if (v < 3) LOADV(v + 1);
#pragma unroll
                for (int dt = 0; dt < 8; ++dt) { f32x4 acc = {0.f, 0.f, 0.f, 0.f};
#pragma unroll
                    for (int kk = 0; kk < 8; ++kk) { const bf16x8 a = *(LAS bf16x8*)(lds + (dt * 16 + fr) * VP + (kk * 32 + fq * 8) * 2); acc = MFMA16(a, pf[kk], acc); }
                    u32x2 o; o.x = cvt_pk_bf16(acc[0], acc[1]); o.y = cvt_pk_bf16(acc[2], acc[3]);
                    *(u32x2*)(OB + (size_t)(t0 + fr) * DM + h * 512 + v * 128 + dt * 16 + fq * 4) = o; }
                if (v < 3) { __syncthreads(); STOREV(); __syncthreads(); }
            }
#undef LOADK
#undef STOREK
#undef LOADV
#undef STOREV
        }
    }
    GRID_SYNC(); STAMP(12);

    {
        pg8::Gemm g{OB, WO, SEQ, DM, DM, DM}; pg8::StaticOrder S; S.init(SEQ, DM, G, bid);
        const CAS gfptr* inp = (const CAS gfptr*)__builtin_amdgcn_kernarg_segment_ptr();
        pg8::EpiResid<false> E{HB, HB, DM, 1.0f, nullptr, nullptr, nullptr, NPC};
        pg8::gemm_phase<pg8::EpiResid<false>, pg8::StaticOrder, true>(lds, g, S, E);
    }
    GRID_SYNC(); STAMP(13);


    {
        pg8::Gemm g{HB, WGU2, SEQ, 2 * DFF, DM, DM}; pg8::StaticOrder S; S.init(SEQ, 2 * DFF, G, bid);
        LAS float* rsl = (LAS float*)(lds + 131072); prep_rstd(S, NPC, rsl);
        pg8::EpiSwiGLU E{ACT2, DFF, rsl};
        pg8::gemm_phase<pg8::EpiSwiGLU, pg8::StaticOrder, true>(lds, g, S, E);
        { PHASE_IDS
            const int ntile = 32 * 44, full = (ntile + G - 1) / G, istart = ntile - (full - 1) * G; const bool all = istart >= G;
            __syncthreads();
            if (all || bid >= istart) CONVERT_RANGE(CV_P4_END, CV_END, (all ? bid : bid - istart), (all ? G : G - istart)); }
    }
    GRID_SYNC(); STAMP(15);

    if (G == 256) {
        const CAS gfptr* inp = (const CAS gfptr*)__builtin_amdgcn_kernarg_segment_ptr();
        pg8::Gemm g{ACT2, WD2, SEQ, DM, DFF, DFF}; pg8::StaticOrder S; S.init(SEQ, DM, G, bid);
        pg8::EpiFinal E{HB, args.out, DM, 0.5f, ((const float*)inp[25]), (float*)(ws + 65536), (unsigned*)(ws + 16384), (LAS float*)(lds + 131072)};
        pg8::gemm_phase<pg8::EpiFinal, pg8::StaticOrder, true>(lds, g, S, E);
    } else {
        {
            pg8::Gemm g{ACT2, WD2, SEQ, DM, DFF, DFF}; pg8::StaticOrder S; S.init(SEQ, DM, G, bid);
            pg8::EpiResid<false> E{HB, HB, DM, 0.5f, nullptr, nullptr, nullptr, nullptr};
            pg8::gemm_phase<pg8::EpiResid<false>, pg8::StaticOrder, true>(lds, g, S, E);
        }
        GRID_SYNC(); STAMP(16);
        { PHASE_IDS
        for (int m = gw; m < SEQ; m += NGW) norm_row_from_bf16(HB + (size_t)m * DM, ((const float*)inp[25]), args.out + (size_t)m * DM, lane);
        }
    }
}

extern "C" void kernel_launch(void* const* d_in, const int* in_sizes, int n_in, void* d_out, int out_size, void* d_ws, size_t ws_size, hipStream_t stream) {
    static int grid = 0;
    if (grid == 0) {
        if (n_in != 26 || out_size != SEQ * DM || ws_size < WS_END) { fprintf(stderr, "kernel_launch: unexpected shapes (n_in %d out %d ws %zu)\n", n_in, out_size, ws_size); grid = -1; return; }
        int dev = 0, cus = 0, per_cu = 0;
        if (hipGetDevice(&dev) != hipSuccess || hipDeviceGetAttribute(&cus, hipDeviceAttributeMultiprocessorCount, dev) != hipSuccess) { grid = -1; return; }
        if (hipFuncSetAttribute((const void*)mega_fwd, hipFuncAttributeMaxDynamicSharedMemorySize, LDS_BYTES) != hipSuccess) { fprintf(stderr, "kernel_launch: hipFuncSetAttribute failed\n"); grid = -1; return; }
        if (hipOccupancyMaxActiveBlocksPerMultiprocessor(&per_cu, (const void*)mega_fwd, 512, LDS_BYTES) != hipSuccess || per_cu < 1) { fprintf(stderr, "kernel_launch: occupancy query failed (%d)\n", per_cu); (void)hipGetLastError(); per_cu = 1; }
        grid = cus * (per_cu < 1 ? 1 : 1);
    }
    if (grid < 0) return;
    if (hipMemsetAsync(d_ws, 0, 32768, stream) != hipSuccess) { fprintf(stderr, "kernel_launch: memset failed\n"); return; }
    Args a{};
    for (int i = 0; i < 26; ++i) a.in[i] = (const float*)d_in[i];
    a.out = (float*)d_out; a.ws = (unsigned char*)d_ws;
    void* kargs[] = {&a};
    hipError_t e = hipLaunchCooperativeKernel((const void*)mega_fwd, dim3(grid), dim3(512), kargs, LDS_BYTES, stream);
    if (e != hipSuccess) fprintf(stderr, "cooperative launch failed: %s (grid %d)\n", hipGetErrorString(e), grid);
}
```
